# Optimizing an MI355X kernel written in HIP

```python
import jax
import jax.numpy as jnp
from jax import lax
import numpy as np

D_MODEL = 1024
BATCH = 1
SEQ = 16384
DEPTH = 4

HEAD_DIM = 64
D_FF = 2816
RMS_EPS = 1e-6
Q_BLOCK = 128
NEG_INF = -1e30

LRU_WIDTH = 768
LRU_BLOCKS = 6
LRU_BLOCK_W = LRU_WIDTH // LRU_BLOCKS
CONV_WIDTH = 4
LRU_C = 8.0

NSA_HEADS = 12
NSA_KV_HEADS = 3
NSA_GROUP = NSA_HEADS // NSA_KV_HEADS
NSA_Q_W = NSA_HEADS * HEAD_DIM
NSA_KV_W = NSA_KV_HEADS * HEAD_DIM
CMP_BLOCK = 32
CMP_STRIDE = 16
CMP_HIDDEN = 256
SEL_BLOCK = 64
SEL_TOPN = 16
WIN = 512
FORCE_SCORE = 1e9

DIL_GROUPS = ((128, 1), (512, 4), (2048, 16))
DIL_HEADS_PER_GROUP = 4
DIL_HEADS = DIL_HEADS_PER_GROUP * len(DIL_GROUPS)
DIL_W = DIL_HEADS * HEAD_DIM
DIL_OUT_W = DIL_HEADS_PER_GROUP * HEAD_DIM
DIL_PAD = max(w for w, _ in DIL_GROUPS)

IN_SPLITS = (LRU_WIDTH, LRU_WIDTH,
             NSA_Q_W,
             NSA_KV_W, NSA_KV_W,
             NSA_KV_W, NSA_KV_W,
             NSA_KV_W, NSA_KV_W,
             NSA_HEADS * 3,
             DIL_W, DIL_W, DIL_W,
             D_MODEL, D_MODEL, D_MODEL)
IN_WIDTH = sum(IN_SPLITS)
IN_OFFSETS = tuple(int(o) for o in np.cumsum(IN_SPLITS)[:-1])

kernel_name = 'hybrid_rglru_nsa_dilated_macaron'


def rms_norm(x, g):
    xf = x.astype(jnp.float32)
    y = xf * lax.rsqrt(jnp.mean(xf * xf, axis=-1, keepdims=True) + RMS_EPS)
    return (y * g.astype(jnp.float32)).astype(x.dtype)


def swiglu(x, w1, w3, w2):
    return (jax.nn.silu(x @ w1) * (x @ w3)) @ w2


def masked_softmax(s, mask):
    s = jnp.where(mask, s, NEG_INF)
    m = jnp.max(s, axis=-1, keepdims=True)
    e = jnp.where(mask, jnp.exp(s - m), 0.0)
    den = jnp.maximum(jnp.sum(e, axis=-1, keepdims=True), 1e-30)
    return e / den, m + jnp.log(den)


def causal_conv(x, w, b):
    S_ = x.shape[1]
    xp = jnp.pad(x, ((0, 0), (CONV_WIDTH - 1, 0), (0, 0)))
    out = b
    for j in range(CONV_WIDTH):
        out = out + w[j] * xp[:, j:j + S_]
    return out


def rg_lru(x, w_a, b_a, w_i, b_i, lam):
    B_, S_, _ = x.shape
    xf = x.astype(jnp.float32)
    xb = xf.reshape(B_, S_, LRU_BLOCKS, LRU_BLOCK_W)
    r = jax.nn.sigmoid(jnp.einsum('bshi,hij->bshj', xb, w_a.astype(jnp.float32)).reshape(B_, S_, LRU_WIDTH) + b_a)
    i = jax.nn.sigmoid(jnp.einsum('bshi,hij->bshj', xb, w_i.astype(jnp.float32)).reshape(B_, S_, LRU_WIDTH) + b_i)
    log_a = -LRU_C * r * jax.nn.softplus(-lam.astype(jnp.float32))
    a = jnp.exp(log_a)
    u = jnp.sqrt(-jnp.expm1(2.0 * log_a)) * (i * xf)

    def combine(c1, c2):
        a1, b1 = c1
        a2, b2 = c2
        return a1 * a2, a2 * b1 + b2

    _, h = lax.associative_scan(combine, (a, u), axis=1)
    return h.astype(x.dtype)


def nsa_attention(q, k_cmp, v_cmp, k_slc, v_slc, k_win, v_win, gate_logits,
                  cmp_pos_k, cmp_pos_v, cmp_k_w1, cmp_k_w2, cmp_v_w1, cmp_v_w2):
    B_, S_ = q.shape[0], q.shape[1]
    scale = HEAD_DIM ** -0.5
    q = q.reshape(B_, S_, NSA_KV_HEADS, NSA_GROUP, HEAD_DIM)
    gates = jax.nn.sigmoid(gate_logits.astype(jnp.float32)).reshape(B_, S_, NSA_KV_HEADS, NSA_GROUP, 3)

    def to_heads(t):
        return t.reshape(B_, S_, NSA_KV_HEADS, HEAD_DIM)

    n_cmp = (S_ - CMP_BLOCK) // CMP_STRIDE + 1
    cmp_idx = np.arange(n_cmp)[:, None] * CMP_STRIDE + np.arange(CMP_BLOCK)[None, :]

    def compress(kv, pos, w1, w2):
        blocks = to_heads(kv)[:, cmp_idx] + pos[None, None, :, None, :]
        blocks = jnp.transpose(blocks, (0, 1, 3, 2, 4)).reshape(B_, n_cmp, NSA_KV_HEADS, CMP_BLOCK * HEAD_DIM)
        return jax.nn.gelu(blocks @ w1) @ w2

    kc = compress(k_cmp, cmp_pos_k, cmp_k_w1, cmp_k_w2)
    vc = compress(v_cmp, cmp_pos_v, cmp_v_w1, cmp_v_w2)
    cmp_end = jnp.asarray(np.arange(n_cmp) * CMP_STRIDE + CMP_BLOCK - 1, jnp.int32)

    n_sel = S_ // SEL_BLOCK
    n_top = min(SEL_TOPN, n_sel)
    sel_of_cmp = jax.nn.one_hot(jnp.asarray(np.arange(n_cmp) * CMP_STRIDE // SEL_BLOCK, jnp.int32),
                                n_sel, dtype=jnp.float32)
    sel_blk = jnp.arange(n_sel, dtype=jnp.int32)
    ks_t = jnp.transpose(to_heads(k_slc), (0, 2, 1, 3))
    vs_t = jnp.transpose(to_heads(v_slc), (0, 2, 1, 3))
    gather_rows = jax.vmap(jax.vmap(lambda src, idx: src[idx]))

    kw_p = jnp.pad(to_heads(k_win), ((0, 0), (WIN, 0), (0, 0), (0, 0)))
    vw_p = jnp.pad(to_heads(v_win), ((0, 0), (WIN, 0), (0, 0), (0, 0)))

    def block(qb):
        start = qb * Q_BLOCK
        t = start + jnp.arange(Q_BLOCK, dtype=jnp.int32)
        qq = lax.dynamic_slice_in_dim(q, start, Q_BLOCK, axis=1)
        gg = lax.dynamic_slice_in_dim(gates, start, Q_BLOCK, axis=1)

        s_c = jnp.einsum('bqkgd,bckd->bkgqc', qq, kc).astype(jnp.float32) * scale
        p_c, _ = masked_softmax(s_c, cmp_end[None, :] <= t[:, None])
        o_c = jnp.einsum('bkgqc,bckd->bqkgd', p_c.astype(vc.dtype), vc)

        imp = jnp.einsum('bkgqc,cn->bkqn', p_c, sel_of_cmp)
        cur = (t // SEL_BLOCK)[:, None]
        imp = jnp.where((sel_blk[None, :] == cur) | (sel_blk[None, :] == 0), FORCE_SCORE,
                        jnp.where(sel_blk[None, :] > cur, -1.0, imp))
        _, top = lax.top_k(imp, n_top)
        n_keys = n_top * SEL_BLOCK
        kpos = (top[..., None] * SEL_BLOCK + jnp.arange(SEL_BLOCK, dtype=jnp.int32)).reshape(
            B_, NSA_KV_HEADS, Q_BLOCK * n_keys)
        k_sel = gather_rows(ks_t, kpos).reshape(B_, NSA_KV_HEADS, Q_BLOCK, n_keys, HEAD_DIM)
        v_sel = gather_rows(vs_t, kpos).reshape(B_, NSA_KV_HEADS, Q_BLOCK, n_keys, HEAD_DIM)
        kpos = kpos.reshape(B_, NSA_KV_HEADS, 1, Q_BLOCK, n_keys)
        s_s = jnp.einsum('bqkgd,bkqnd->bkgqn', qq, k_sel).astype(jnp.float32) * scale
        p_s, _ = masked_softmax(s_s, kpos <= t[:, None])
        o_s = jnp.einsum('bkgqn,bkqnd->bqkgd', p_s.astype(v_sel.dtype), v_sel)

        k_w = lax.dynamic_slice_in_dim(kw_p, start, WIN + Q_BLOCK, axis=1)
        v_w = lax.dynamic_slice_in_dim(vw_p, start, WIN + Q_BLOCK, axis=1)
        wpos = start - WIN + jnp.arange(WIN + Q_BLOCK, dtype=jnp.int32)
        dist = t[:, None] - wpos[None, :]
        s_w = jnp.einsum('bqkgd,bskd->bkgqs', qq, k_w).astype(jnp.float32) * scale
        p_w, _ = masked_softmax(s_w, (dist >= 0) & (dist < WIN) & (wpos[None, :] >= 0))
        o_w = jnp.einsum('bkgqs,bskd->bqkgd', p_w.astype(v_w.dtype), v_w)

        o = gg[..., 0:1] * o_c + gg[..., 1:2] * o_s + gg[..., 2:3] * o_w
        return o.reshape(B_, Q_BLOCK, NSA_Q_W).astype(q.dtype)

    out = lax.map(block, jnp.arange(S_ // Q_BLOCK, dtype=jnp.int32))
    return jnp.transpose(out, (1, 0, 2, 3)).reshape(B_, S_, NSA_Q_W)


def dilated_attention(q, k, v):
    B_, S_ = q.shape[0], q.shape[1]
    scale = HEAD_DIM ** -0.5
    n_grp = len(DIL_GROUPS)
    shp = (B_, S_, n_grp, DIL_HEADS_PER_GROUP, HEAD_DIM)
    q = q.reshape(shp)
    pad = ((0, 0), (DIL_PAD, 0), (0, 0), (0, 0), (0, 0))
    k_p = jnp.pad(k.reshape(shp), pad)
    v_p = jnp.pad(v.reshape(shp), pad)

    def block(qb):
        start = qb * Q_BLOCK
        t = start + jnp.arange(Q_BLOCK, dtype=jnp.int32)
        qq = lax.dynamic_slice_in_dim(q, start, Q_BLOCK, axis=1)
        outs, lses = [], []
        for gi, (window, dil) in enumerate(DIL_GROUPS):
            n_keys = window // dil + 1
            kpos = t[:, None] - dil * jnp.arange(n_keys, dtype=jnp.int32)[None, :]
            idx = (kpos + DIL_PAD).reshape(-1)
            kg = jnp.take(k_p[:, :, gi], idx, axis=1).reshape(B_, Q_BLOCK, n_keys, DIL_HEADS_PER_GROUP, HEAD_DIM)
            vg = jnp.take(v_p[:, :, gi], idx, axis=1).reshape(B_, Q_BLOCK, n_keys, DIL_HEADS_PER_GROUP, HEAD_DIM)
            s = jnp.einsum('bqhd,bqnhd->bhqn', qq[:, :, gi], kg).astype(jnp.float32) * scale
            p, lse = masked_softmax(s, kpos >= 0)
            outs.append(jnp.einsum('bhqn,bqnhd->bqhd', p.astype(vg.dtype), vg))
            lses.append(jnp.transpose(lse[..., 0], (0, 2, 1)))
        wts = jax.nn.softmax(jnp.stack(lses, axis=-1), axis=-1)
        o = jnp.sum(jnp.stack(outs, axis=-1) * wts[:, :, :, None, :], axis=-1)
        return o.reshape(B_, Q_BLOCK, DIL_OUT_W).astype(q.dtype)

    out = lax.map(block, jnp.arange(S_ // Q_BLOCK, dtype=jnp.int32))
    return jnp.transpose(out, (1, 0, 2, 3)).reshape(B_, S_, DIL_OUT_W)


def hybrid_mixer(h, w_in, conv_w, conv_b, lru_wa, lru_ba, lru_wi, lru_bi, lru_lambda,
                 cmp_pos_k, cmp_pos_v, cmp_k_w1, cmp_k_w2, cmp_v_w1, cmp_v_w2,
                 w_up_a, w_up_b, w_up_c, w_out):
    (a_x, a_gate, b_q, b_kc, b_vc, b_ks, b_vs, b_kw, b_vw, b_gate,
     c_q, c_k, c_v, m_a, m_b, m_c) = jnp.split(h @ w_in, list(IN_OFFSETS), axis=-1)
    y_a = rg_lru(causal_conv(a_x, conv_w, conv_b), lru_wa, lru_ba, lru_wi, lru_bi, lru_lambda)
    y_a = (y_a * jax.nn.gelu(a_gate)) @ w_up_a
    y_b = nsa_attention(b_q, b_kc, b_vc, b_ks, b_vs, b_kw, b_vw, b_gate,
                        cmp_pos_k, cmp_pos_v, cmp_k_w1, cmp_k_w2, cmp_v_w1, cmp_v_w2) @ w_up_b
    y_c = dilated_attention(c_q, c_k, c_v) @ w_up_c
    merged = jax.nn.sigmoid(m_a) * y_a + jax.nn.sigmoid(m_b) * y_b + jax.nn.sigmoid(m_c) * y_c
    return merged @ w_out


def _normal(key, shape, scale):
    return jax.random.normal(key, shape, jnp.float32) * scale


def setup_inputs(seed: int = 0) -> dict:
    key = jax.random.key(seed)
    k = jax.random.split(key, 32)
    L = DEPTH
    a_lo, a_hi = 0.9 ** (1.0 / LRU_C), 0.999 ** (1.0 / LRU_C)
    a0 = jax.random.uniform(k[13], (L, LRU_WIDTH), jnp.float32, a_lo, a_hi)
    flat = CMP_BLOCK * HEAD_DIM
    return {
        'x': _normal(k[0], (BATCH, SEQ, D_MODEL), 1.0),
        'ffn1_norm': 1.0 + _normal(k[1], (L, D_MODEL), 0.01),
        'ffn1_w1': _normal(k[2], (L, D_MODEL, D_FF), D_MODEL ** -0.5),
        'ffn1_w3': _normal(k[3], (L, D_MODEL, D_FF), D_MODEL ** -0.5),
        'ffn1_w2': _normal(k[4], (L, D_FF, D_MODEL), D_FF ** -0.5),
        'mix_norm': 1.0 + _normal(k[5], (L, D_MODEL), 0.01),
        'w_in': _normal(k[6], (L, D_MODEL, IN_WIDTH), D_MODEL ** -0.5),
        'conv_w': _normal(k[7], (L, CONV_WIDTH, LRU_WIDTH), CONV_WIDTH ** -0.5),
        'conv_b': _normal(k[8], (L, LRU_WIDTH), 0.01),
        'lru_wa': _normal(k[9], (L, LRU_BLOCKS, LRU_BLOCK_W, LRU_BLOCK_W), LRU_BLOCK_W ** -0.5),
        'lru_ba': _normal(k[10], (L, LRU_WIDTH), 0.01),
        'lru_wi': _normal(k[11], (L, LRU_BLOCKS, LRU_BLOCK_W, LRU_BLOCK_W), LRU_BLOCK_W ** -0.5),
        'lru_bi': _normal(k[12], (L, LRU_WIDTH), 0.01),
        'lru_lambda': jnp.log(a0) - jnp.log1p(-a0),
        'cmp_pos_k': _normal(k[14], (L, CMP_BLOCK, HEAD_DIM), 0.1),
        'cmp_pos_v': _normal(k[15], (L, CMP_BLOCK, HEAD_DIM), 0.1),
        'cmp_k_w1': _normal(k[16], (L, flat, CMP_HIDDEN), flat ** -0.5),
        'cmp_k_w2': _normal(k[17], (L, CMP_HIDDEN, HEAD_DIM), CMP_HIDDEN ** -0.5),
        'cmp_v_w1': _normal(k[18], (L, flat, CMP_HIDDEN), flat ** -0.5),
        'cmp_v_w2': _normal(k[19], (L, CMP_HIDDEN, HEAD_DIM), CMP_HIDDEN ** -0.5),
        'w_up_a': _normal(k[20], (L, LRU_WIDTH, D_MODEL), LRU_WIDTH ** -0.5),
        'w_up_b': _normal(k[21], (L, NSA_Q_W, D_MODEL), NSA_Q_W ** -0.5),
        'w_up_c': _normal(k[22], (L, DIL_OUT_W, D_MODEL), DIL_OUT_W ** -0.5),
        'w_out': _normal(k[23], (L, D_MODEL, D_MODEL), D_MODEL ** -0.5),
        'ffn2_norm': 1.0 + _normal(k[24], (L, D_MODEL), 0.01),
        'ffn2_w1': _normal(k[25], (L, D_MODEL, D_FF), D_MODEL ** -0.5),
        'ffn2_w3': _normal(k[26], (L, D_MODEL, D_FF), D_MODEL ** -0.5),
        'ffn2_w2': _normal(k[27], (L, D_FF, D_MODEL), D_FF ** -0.5),
        'final_norm': 1.0 + _normal(k[28], (D_MODEL,), 0.01),
    }


def reference(x, ffn1_norm, ffn1_w1, ffn1_w3, ffn1_w2, mix_norm, w_in, conv_w, conv_b,
              lru_wa, lru_ba, lru_wi, lru_bi, lru_lambda, cmp_pos_k, cmp_pos_v,
              cmp_k_w1, cmp_k_w2, cmp_v_w1, cmp_v_w2, w_up_a, w_up_b, w_up_c, w_out,
              ffn2_norm, ffn2_w1, ffn2_w3, ffn2_w2, final_norm):
    for l in range(DEPTH):
        x = x + 0.5 * swiglu(rms_norm(x, ffn1_norm[l]), ffn1_w1[l], ffn1_w3[l], ffn1_w2[l])
        x = x + hybrid_mixer(rms_norm(x, mix_norm[l]), w_in[l], conv_w[l], conv_b[l],
                             lru_wa[l], lru_ba[l], lru_wi[l], lru_bi[l], lru_lambda[l],
                             cmp_pos_k[l], cmp_pos_v[l], cmp_k_w1[l], cmp_k_w2[l],
                             cmp_v_w1[l], cmp_v_w2[l], w_up_a[l], w_up_b[l], w_up_c[l], w_out[l])
        x = x + 0.5 * swiglu(rms_norm(x, ffn2_norm[l]), ffn2_w1[l], ffn2_w3[l], ffn2_w2[l])
    return rms_norm(x, final_norm)
```

```cpp
#include <hip/hip_runtime.h>
#include <hip/hip_cooperative_groups.h>
#include <cstdio>
#include <cstdint>
namespace cg = cooperative_groups;
namespace pg8 {
#define PG8_LAS __attribute__((address_space(3)))
typedef unsigned short bf16_t;
typedef short bf16x8 __attribute__((ext_vector_type(8)));
typedef float f32x4 __attribute__((ext_vector_type(4)));
typedef unsigned u32x4 __attribute__((ext_vector_type(4)));
constexpr int BM = 256, BK = 64, HALF = 128, HTB = HALF * BK * 2  , STAGE_BYTES = 8 * HTB, NXCD = 8, WGM = 8;

__host__ __device__ __forceinline__ int lds_byte(int r, int c) { const int st = (r >> 4) * 2 + (c >> 5), rr = r & 15, cc = c & 31, ob = rr * 64 + cc * 2; return st * 1024 + (ob ^ (((ob >> 9) & 1) << 5)); }
__host__ __device__ __forceinline__ void stage_rc(int b, int& R, int& C) { const int st = b / 1024, sb = b % 1024, swz = sb ^ (((sb >> 9) & 1) << 5); R = (st >> 1) * 16 + swz / 64; C = (st & 1) * 32 + (swz % 64) / 2; }
__host__ __device__ __forceinline__ int perm32(int rho) { const int n = rho >> 4, i = rho & 15; return 8 * (i >> 2) + 4 * n + (i & 3); }

struct Unit { int pm, pn; };
struct Gemm { const bf16_t* A; const bf16_t* Bt; int M, N, K; };

struct StaticOrder {
    int nM, nN, nwg, G, c;
    __host__ __device__ void init(int M, int N, int G_, int c_) { nM = M / BM; nN = N / BM; nwg = nM * nN; G = G_; c = c_; }
    __host__ __device__ bool next(int i, Unit& u) const {
        const long L = (long)i * G + c; if (L >= nwg) return false;
        int wgid = (int)L; { const int q = nwg / NXCD, r = nwg % NXCD, xcd = wgid % NXCD, off = wgid / NXCD; wgid = (xcd < r ? xcd * (q + 1) : r * (q + 1) + (xcd - r) * q) + off; }
        const int nig = WGM * nN, gid = wgid / nig, fm = gid * WGM, gsz = (nM - fm) < WGM ? (nM - fm) : WGM;
        u.pm = fm + ((wgid % nig) % gsz); u.pn = (wgid % nig) / gsz; return true;
    }
    __device__ __forceinline__ void a_ready(const Unit&) const {}
    __device__ __forceinline__ void done(const Unit&) const {}
};

typedef unsigned u32x2 __attribute__((ext_vector_type(2)));
typedef float f32x2_t __attribute__((ext_vector_type(2))); typedef __bf16 bf16x2_t __attribute__((ext_vector_type(2)));
__device__ __forceinline__ unsigned cvt_pk_bf16(float lo, float hi) { const f32x2_t v = {lo, hi}; const bf16x2_t b = __builtin_convertvector(v, bf16x2_t); return __builtin_bit_cast(unsigned, b); }
__device__ __forceinline__ float bflo(unsigned u) { return __uint_as_float(u << 16); }
__device__ __forceinline__ float bfhi(unsigned u) { return __uint_as_float(u & 0xffff0000u); }
__device__ __forceinline__ float sigm(float v) { return __builtin_amdgcn_rcpf(1.f + __expf(-v)); }
__device__ __forceinline__ float gelu_t(float v) { const float u = 1.5957691216f * (v + 0.044715f * v * v * v); return v * sigm(u); }

constexpr int DM = 1024, DFF = 2816, PW = 8960;
constexpr float RMS_EPS = 1e-6f;
__device__ __forceinline__ float rsum16(const float* ssq, int row) { const f32x4* p = (const f32x4*)(ssq + (size_t)row * 16); const f32x4 a = p[0], b = p[1], c = p[2], d = p[3];
    return (((a[0] + a[1]) + (a[2] + a[3])) + ((b[0] + b[1]) + (b[2] + b[3]))) + (((c[0] + c[1]) + (c[2] + c[3])) + ((d[0] + d[1]) + (d[2] + d[3]))); }
constexpr int PC_AX = 0, PC_AG = 768, PC_BQ = 1536, PC_CQ = 2304, PC_CK = 3072, PC_CV = 3840, PC_MA = 4608, PC_MB = 5632, PC_MC = 6656,
              PC_KC = 7680, PC_VC = 7872, PC_KS = 8064, PC_VS = 8256, PC_KW = 8448, PC_VW = 8640, PC_BG = 8832;
constexpr float QSCALE = 0.125f * 1.4426950408889634f;

struct EpiSwiGLU {
    static constexpr bool PERM = true, AFTER_DRAIN = false;
    bf16_t* H; const float* ssq;
    __device__ __forceinline__ void operator()(const f32x4 (&acc)[2][2][4][2], const Unit& u, int wr, int wc, int fr, int fq) const {
        const int row0 = u.pm * BM + wr * 64 + fr; const int hc0 = u.pn * 128 + wc * 16 + 4 * fq;
#pragma unroll
        for (int ai = 0; ai < 2; ++ai)
#pragma unroll
            for (int m = 0; m < 4; ++m) { const int row = row0 + ai * HALF + m * 16; const float rs = rsqrtf(rsum16(ssq, row) * (1.f / DM) + RMS_EPS);
#pragma unroll
                for (int bj = 0; bj < 2; ++bj) { const f32x4 a = acc[ai][bj][m][0] * rs, b = acc[ai][bj][m][1] * rs; float h[4];
#pragma unroll
                    for (int i = 0; i < 4; ++i) h[i] = a[i] * sigm(a[i]) * b[i];
                    u32x2 w; w.x = cvt_pk_bf16(h[0], h[1]); w.y = cvt_pk_bf16(h[2], h[3]);
                    *(u32x2*)(H + (size_t)row * DFF + hc0 + bj * 64) = w; } }
    }
};
struct EpiResid {
    static constexpr bool PERM = false, AFTER_DRAIN = false;
    float* X; bf16_t* XB; float* ssq_out; float scale;
    __device__ __forceinline__ void operator()(const f32x4 (&acc)[2][2][4][2], const Unit& u, int wr, int wc, int fr, int fq) const {
        const int row0 = u.pm * BM + wr * 64 + fr; const int col0 = u.pn * BM + wc * 32 + 4 * fq;
#pragma unroll
        for (int ai = 0; ai < 2; ++ai)
#pragma unroll
            for (int m = 0; m < 4; ++m) { const int row = row0 + ai * HALF + m * 16; float ss = 0.f;
#pragma unroll
                for (int bj = 0; bj < 2; ++bj)
#pragma unroll
                    for (int n = 0; n < 2; ++n) { const size_t off = (size_t)row * DM + col0 + bj * HALF + n * 16;
                        f32x4 xv = *(const f32x4*)(X + off); xv = xv + acc[ai][bj][m][n] * scale; *(f32x4*)(X + off) = xv;
                        u32x2 w; w.x = cvt_pk_bf16(xv[0], xv[1]); w.y = cvt_pk_bf16(xv[2], xv[3]); *(u32x2*)(XB + off) = w;
                        ss += (xv[0] * xv[0] + xv[1] * xv[1]) + (xv[2] * xv[2] + xv[3] * xv[3]); }
                ss += __shfl_xor(ss, 16); ss += __shfl_xor(ss, 32);
                if (fq == 0) ssq_out[(size_t)row * 16 + u.pn * 4 + wc] = ss; }
    }
};
struct EpiProj {
    static constexpr bool PERM = true, AFTER_DRAIN = false;
    bf16_t* P; const float* ssq;
    __device__ __forceinline__ void operator()(const f32x4 (&acc)[2][2][4][2], const Unit& u, int wr, int wc, int fr, int fq) const {
        const int row0 = u.pm * BM + wr * 64 + fr; const int col0 = u.pn * BM + wc * 32 + 8 * fq;
        const int pn = u.pn; const int act = (pn >= 3 && pn < 6) ? 1 : (pn >= 6 && pn < 12) ? 2 : (pn >= 18 && pn < 30) ? 3 : 0;
#pragma unroll
        for (int ai = 0; ai < 2; ++ai)
#pragma unroll
            for (int m = 0; m < 4; ++m) { const int row = row0 + ai * HALF + m * 16; float rs = rsqrtf(rsum16(ssq, row) * (1.f / DM) + RMS_EPS); if (act == 2) rs *= QSCALE;
#pragma unroll
                for (int bj = 0; bj < 2; ++bj) { f32x4 v0 = acc[ai][bj][m][0] * rs, v1 = acc[ai][bj][m][1] * rs;
                    if (act == 1) {
#pragma unroll
                        for (int i = 0; i < 4; ++i) { v0[i] = gelu_t(v0[i]); v1[i] = gelu_t(v1[i]); } }
                    else if (act == 3) {
#pragma unroll
                        for (int i = 0; i < 4; ++i) { v0[i] = sigm(v0[i]); v1[i] = sigm(v1[i]); } }
                    u32x4 w; w.x = cvt_pk_bf16(v0[0], v0[1]); w.y = cvt_pk_bf16(v0[2], v0[3]); w.z = cvt_pk_bf16(v1[0], v1[1]); w.w = cvt_pk_bf16(v1[2], v1[3]);
                    *(u32x4*)(P + (size_t)row * PW + col0 + bj * HALF) = w; } }
    }
};
template <int ACCUM> struct EpiMerge {
    static constexpr bool PERM = true, AFTER_DRAIN = false;
    bf16_t* Mg; const bf16_t* G;
    __device__ __forceinline__ void operator()(const f32x4 (&acc)[2][2][4][2], const Unit& u, int wr, int wc, int fr, int fq) const {
        const int row0 = u.pm * BM + wr * 64 + fr; const int col0 = u.pn * BM + wc * 32 + 8 * fq;
#pragma unroll
        for (int ai = 0; ai < 2; ++ai)
#pragma unroll
            for (int m = 0; m < 4; ++m) { const int row = row0 + ai * HALF + m * 16;
#pragma unroll
                for (int bj = 0; bj < 2; ++bj) { const u32x4 g = *(const u32x4*)(G + (size_t)row * PW + col0 + bj * HALF);
                    const f32x4 a0 = acc[ai][bj][m][0], a1 = acc[ai][bj][m][1];
                    float v[8] = {bflo(g.x) * a0[0], bfhi(g.x) * a0[1], bflo(g.y) * a0[2], bfhi(g.y) * a0[3], bflo(g.z) * a1[0], bfhi(g.z) * a1[1], bflo(g.w) * a1[2], bfhi(g.w) * a1[3]};
                    bf16_t* mp = Mg + (size_t)row * DM + col0 + bj * HALF;
                    if (ACCUM) { const u32x4 o = *(const u32x4*)mp; v[0] += bflo(o.x); v[1] += bfhi(o.x); v[2] += bflo(o.y); v[3] += bfhi(o.y); v[4] += bflo(o.z); v[5] += bfhi(o.z); v[6] += bflo(o.w); v[7] += bfhi(o.w); }
                    u32x4 w; w.x = cvt_pk_bf16(v[0], v[1]); w.y = cvt_pk_bf16(v[2], v[3]); w.z = cvt_pk_bf16(v[4], v[5]); w.w = cvt_pk_bf16(v[6], v[7]);
                    *(u32x4*)mp = w; } }
    }
};

template <class Epi, class Sched, bool ALIGN_EPI = false, bool SP2 = false>
__device__ __forceinline__ void gemm_phase(PG8_LAS unsigned char* lds, const Gemm g, const Sched& S, const Epi& E) {
    int tid = threadIdx.x; asm volatile("" : "+v"(tid));
    const int wid = __builtin_amdgcn_readfirstlane(tid >> 6), lane = tid & 63, wr = wid >> 2, wc = wid & 3, fr = lane & 15, fq = lane >> 4;
    const int K = g.K, nt = K / BK;
    unsigned voffA[2], voffB[2];
#pragma unroll
    for (int i = 0; i < 2; ++i) { int R, C; stage_rc(tid * 16 + i * 8192, R, C); const int Rb = Epi::PERM ? ((R & ~31) + perm32(R & 31)) : R;
        voffA[i] = (unsigned)(R * K + C) * 2u; voffB[i] = (unsigned)(Rb * K + C) * 2u; }
    const size_t kstep = (size_t)(BK * 2);
    const size_t hstep = (size_t)HALF * K * 2;
    const size_t tstep = 2 * hstep;
    const unsigned ldsw = (unsigned)wid * 1024u;
    const int aoff = lds_byte(wr * 64 + fr, fq * 8), boff = lds_byte(wc * 32 + fr, fq * 8);
#define PG8_SA(b, h) (((b) * 2 + (h)) * HTB)
#define PG8_SB(b, h) ((4 + (b) * 2 + (h)) * HTB)
#define PG8_STAGE(bufoff, gbase, voff) do { _Pragma("unroll") for (int _i = 0; _i < 2; ++_i) \
        __builtin_amdgcn_global_load_lds((const unsigned*)((const char*)(gbase) + (voff)[_i]), (PG8_LAS unsigned*)(lds + (bufoff) + ldsw + _i * 8192), 16, 0, 0); } while (0)
#define PG8_LDA(dst, b, h) do { _Pragma("unroll") for (int m = 0; m < 4; ++m) _Pragma("unroll") for (int k = 0; k < 2; ++k) dst[m][k] = *(const PG8_LAS bf16x8*)(lds + PG8_SA(b, h) + aoff + m * 2048 + k * 1024); } while (0)
#define PG8_LDB(dst, b, h) do { _Pragma("unroll") for (int n = 0; n < 2; ++n) _Pragma("unroll") for (int k = 0; k < 2; ++k) dst[n][k] = *(const PG8_LAS bf16x8*)(lds + PG8_SB(b, h) + boff + n * 2048 + k * 1024); } while (0)
#define PG8_MMA(ai, bj, At, Bt) do { __builtin_amdgcn_s_setprio(1); _Pragma("unroll") for (int m = 0; m < 4; ++m) _Pragma("unroll") for (int n = 0; n < 2; ++n) _Pragma("unroll") for (int k = 0; k < 2; ++k) \
        acc[ai][bj][m][n] = __builtin_amdgcn_mfma_f32_16x16x32_bf16(Bt[n][k], At[m][k], acc[ai][bj][m][n], 0, 0, 0); __builtin_amdgcn_s_setprio(0); } while (0)
#define PG8_WAIT_V(n) asm volatile("s_waitcnt vmcnt(" #n ")" ::: "memory")
#define PG8_WAIT_L(n) asm volatile("s_waitcnt lgkmcnt(" #n ")" ::: "memory")
#define PG8_BAR __builtin_amdgcn_s_barrier()
#define PG8_SCHED __builtin_amdgcn_sched_barrier(0)
    Unit cur, nxt; int ui = 0;
    if (!S.next(0, cur)) return;
    f32x4 acc[2][2][4][2];
#pragma unroll
    for (int a = 0; a < 2; ++a)
#pragma unroll
        for (int b = 0; b < 2; ++b)
#pragma unroll
            for (int m = 0; m < 4; ++m)
#pragma unroll
                for (int n = 0; n < 2; ++n) acc[a][b][m][n] = (f32x4){0.f, 0.f, 0.f, 0.f};
    bf16x8 At[4][2], B0[2][2], B1[2][2];
    const char* cA = (const char*)g.A + (size_t)cur.pm * tstep; const char* cB = (const char*)g.Bt + (size_t)cur.pn * tstep;
    S.a_ready(cur);
    if constexpr (SP2) {
        PG8_STAGE(PG8_SB(0, 0), cB, voffB); PG8_STAGE(PG8_SB(0, 1), cB + hstep, voffB); PG8_STAGE(PG8_SA(0, 0), cA, voffA); PG8_STAGE(PG8_SA(0, 1), cA + hstep, voffA);
        if (wr == 1) PG8_BAR;
        PG8_WAIT_V(2); PG8_BAR;
        PG8_STAGE(PG8_SB(1, 0), cB + kstep, voffB); PG8_STAGE(PG8_SA(1, 0), cA + kstep, voffA); PG8_STAGE(PG8_SB(1, 1), cB + hstep + kstep, voffB);
        PG8_WAIT_V(6); PG8_BAR;
    } else {
        PG8_STAGE(PG8_SB(0, 0), cB, voffB); PG8_STAGE(PG8_SA(0, 0), cA, voffA); PG8_STAGE(PG8_SB(0, 1), cB + hstep, voffB); PG8_STAGE(PG8_SA(0, 1), cA + hstep, voffA);
        if (wr == 1) PG8_BAR;
        PG8_WAIT_V(4); PG8_BAR;
        PG8_STAGE(PG8_SB(1, 0), cB + kstep, voffB); PG8_STAGE(PG8_SA(1, 0), cA + kstep, voffA); PG8_STAGE(PG8_SB(1, 1), cB + hstep + kstep, voffB);
        PG8_WAIT_V(6); PG8_BAR;
    }
    for (;;) {
        const bool has_next = S.next(ui + 1, nxt);
        const char* nA = has_next ? (const char*)g.A + (size_t)nxt.pm * tstep : cA; const char* nB = has_next ? (const char*)g.Bt + (size_t)nxt.pn * tstep : cB;
        for (int t = 0; t < nt; t += 2) {
            const bool last = (t == nt - 2);
            const char* a1 = cA + (size_t)(t + 1) * kstep;
            const char* a2 = last ? nA : cA + (size_t)(t + 2) * kstep; const char* b2 = last ? nB : cB + (size_t)(t + 2) * kstep;
            const char* a3 = a2 + kstep; const char* b3 = b2 + kstep;
            if (last && has_next) S.a_ready(nxt);
            if constexpr (SP2) {
            PG8_LDB(B0, 0, 0); PG8_LDB(B1, 0, 1); PG8_SCHED; PG8_LDA(At, 0, 0); PG8_STAGE(PG8_SA(1, 1), a1 + hstep, voffA);
            PG8_WAIT_V(8); PG8_WAIT_L(0); PG8_BAR; PG8_MMA(0, 0, At, B0); PG8_MMA(0, 1, At, B1); PG8_BAR; PG8_SCHED;
            PG8_LDA(At, 0, 1); PG8_STAGE(PG8_SB(0, 0), b2, voffB); PG8_STAGE(PG8_SB(0, 1), b2 + hstep, voffB); PG8_STAGE(PG8_SA(0, 0), a2, voffA);
            PG8_WAIT_V(8); PG8_WAIT_L(0); PG8_BAR; PG8_MMA(1, 0, At, B0); PG8_MMA(1, 1, At, B1); PG8_BAR; PG8_SCHED;
            PG8_LDB(B0, 1, 0); PG8_LDB(B1, 1, 1); PG8_SCHED; PG8_LDA(At, 1, 0); PG8_STAGE(PG8_SA(0, 1), a2 + hstep, voffA);
            PG8_WAIT_V(8); PG8_WAIT_L(0); PG8_BAR; PG8_MMA(0, 0, At, B0); PG8_MMA(0, 1, At, B1); PG8_BAR; PG8_SCHED;
            PG8_LDA(At, 1, 1); PG8_STAGE(PG8_SB(1, 0), b3, voffB); PG8_STAGE(PG8_SB(1, 1), b3 + hstep, voffB); PG8_STAGE(PG8_SA(1, 0), a3, voffA);
            PG8_WAIT_V(8); PG8_WAIT_L(0); PG8_BAR; PG8_MMA(1, 0, At, B0); PG8_MMA(1, 1, At, B1); PG8_BAR; PG8_SCHED;
            } else {
            PG8_LDB(B0, 0, 0); PG8_SCHED; PG8_LDA(At, 0, 0); PG8_STAGE(PG8_SA(1, 1), a1 + hstep, voffA);
            PG8_WAIT_L(8); PG8_BAR; PG8_WAIT_L(0); PG8_MMA(0, 0, At, B0); PG8_BAR; PG8_SCHED;
            PG8_LDB(B1, 0, 1); PG8_STAGE(PG8_SB(0, 0), b2, voffB);
            PG8_BAR; PG8_WAIT_L(0); PG8_MMA(0, 1, At, B1); PG8_BAR;
            PG8_LDA(At, 0, 1); PG8_STAGE(PG8_SA(0, 0), a2, voffA);
            PG8_BAR; PG8_WAIT_L(0); PG8_MMA(1, 0, At, B0); PG8_BAR; PG8_SCHED;
            PG8_STAGE(PG8_SB(0, 1), b2 + hstep, voffB);
            PG8_WAIT_V(6); PG8_BAR; PG8_MMA(1, 1, At, B1); PG8_BAR;
            PG8_LDB(B0, 1, 0); PG8_SCHED; PG8_LDA(At, 1, 0); PG8_STAGE(PG8_SA(0, 1), a2 + hstep, voffA);
            PG8_WAIT_L(8); PG8_BAR; PG8_WAIT_L(0); PG8_MMA(0, 0, At, B0); PG8_BAR; PG8_SCHED;
            PG8_LDB(B1, 1, 1); PG8_STAGE(PG8_SB(1, 0), b3, voffB);
            PG8_BAR; PG8_WAIT_L(0); PG8_MMA(0, 1, At, B1); PG8_BAR;
            PG8_LDA(At, 1, 1); PG8_STAGE(PG8_SA(1, 0), a3, voffA);
            PG8_BAR; PG8_WAIT_L(0); PG8_MMA(1, 0, At, B0); PG8_BAR; PG8_SCHED;
            PG8_STAGE(PG8_SB(1, 1), b3 + hstep, voffB);
            PG8_WAIT_V(6); PG8_BAR; PG8_MMA(1, 1, At, B1); PG8_BAR;
            }
        }
        if constexpr (ALIGN_EPI) { if (wr == 0) PG8_BAR; }
        if constexpr (!Epi::AFTER_DRAIN) { E(acc, cur, wr, wc, fr, fq); S.done(cur); }
        if (!has_next) break;
#pragma unroll
        for (int a = 0; a < 2; ++a)
#pragma unroll
            for (int b = 0; b < 2; ++b)
#pragma unroll
                for (int m = 0; m < 4; ++m)
#pragma unroll
                    for (int n = 0; n < 2; ++n) acc[a][b][m][n] = (f32x4){0.f, 0.f, 0.f, 0.f};
        cur = nxt; cA = nA; cB = nB; ++ui;
        if constexpr (ALIGN_EPI) { if (wr == 1) PG8_BAR; }
    }
    PG8_WAIT_V(0);
    if constexpr (!ALIGN_EPI) { if (wr == 0) PG8_BAR; }
    PG8_BAR;
    if constexpr (Epi::AFTER_DRAIN) { E.fused(acc, cur, wr, wc, fr, fq, lds, wid, lane); S.done(cur); }
#undef PG8_SA
#undef PG8_SB
#undef PG8_STAGE
#undef PG8_LDA
#undef PG8_LDB
#undef PG8_MMA
#undef PG8_WAIT_V
#undef PG8_WAIT_L
#undef PG8_BAR
#undef PG8_SCHED
}
}
using pg8::bf16_t; using pg8::bf16x8; using pg8::f32x4; using pg8::u32x4; using pg8::u32x2;
using pg8::cvt_pk_bf16; using pg8::bflo; using pg8::bfhi; using pg8::sigm; using pg8::gelu_t;
using namespace pg8;
#define LAS __attribute__((address_space(3)))
typedef LAS unsigned char* ldsp;
constexpr int S = 16384, NL = 4, NT = 512;
constexpr int LDS_BYTES = 147456;
constexpr size_t al256(size_t x) { return (x + 255) & ~(size_t)255; }
constexpr size_t WS_SSQ = 0;
constexpr size_t WS_CTR = WS_SSQ + 16 * (size_t)S * 4;
constexpr size_t WS_BIASP = WS_CTR + 1024;
constexpr size_t WS_BAR = al256(WS_BIASP + 16 * 256 * 4);
constexpr size_t WS_LSE = al256(WS_BAR + 16384);
constexpr size_t WS_ATOT = al256(WS_LSE + (size_t)12 * S * 4);
constexpr size_t WS_HEND = WS_ATOT + 256 * 768 * 4;
constexpr size_t WS_KC = WS_HEND + 256 * 768 * 4;
constexpr size_t WS_VCT = WS_KC + 3 * 1024 * 64 * 2;
constexpr size_t WS_WT = al256(WS_VCT + 3 * 1024 * 64 * 2);
constexpr size_t WT_W13A = 0, WT_W2A = WT_W13A + (size_t)5632 * 1024 * 2, WT_WIN = WT_W2A + (size_t)1024 * 2816 * 2, WT_LRU = WT_WIN + (size_t)8960 * 1024 * 2,
                 WT_C1K = WT_LRU + 6 * 256 * 128 * 2, WT_C1V = WT_C1K + 256 * 2048 * 2, WT_C2K = WT_C1V + 256 * 2048 * 2, WT_C2V = WT_C2K + 64 * 256 * 2,
                 WT_UA = WT_C2V + 64 * 256 * 2, WT_UB = WT_UA + 1024 * 768 * 2, WT_UC = WT_UB + 1024 * 768 * 2, WT_WO = WT_UC + 1024 * 256 * 2,
                 WT_W13B = WT_WO + 1024 * 1024 * 2, WT_W2B = WT_W13B + (size_t)5632 * 1024 * 2, WT_END = WT_W2B + (size_t)1024 * 2816 * 2;
constexpr size_t WS_XB = al256(WS_WT + WT_END);
constexpr size_t WS_YA = WS_XB + (size_t)S * 1024 * 2;
constexpr size_t WS_HLOC = WS_YA + (size_t)S * 768 * 2;
constexpr size_t WS_CUMP = WS_HLOC + (size_t)S * 768 * 2;
constexpr size_t WS_NSAO = WS_CUMP + (size_t)S * 768 * 2;
constexpr size_t WS_DILO = WS_NSAO + (size_t)S * 768 * 2;
constexpr size_t WS_VTS = WS_DILO + (size_t)S * 256 * 2;
constexpr size_t WS_VTW = WS_VTS + (size_t)3 * 64 * S * 2;
constexpr size_t WS_VTC = WS_VTW + (size_t)3 * 64 * S * 2;
constexpr size_t WS_MERGED = WS_VTS;
constexpr size_t WS_P = WS_VTC + (size_t)12 * 64 * S * 2;
constexpr size_t WS_HID = WS_P;
constexpr size_t WS_END = WS_P + (size_t)S * PW * 2;
static_assert((size_t)S * 1024 * 2 <= (size_t)18 * 64 * S * 2, "merged fits the VT region");

struct Args { const float* in[29]; float* out; unsigned char* ws; };
enum { I_X = 0, I_F1N, I_F1W1, I_F1W3, I_F1W2, I_MIXN, I_WIN, I_CONVW, I_CONVB, I_LRUWA, I_LRUBA, I_LRUWI, I_LRUBI, I_LAM, I_POSK, I_POSV,
       I_CK1, I_CK2, I_CV1, I_CV2, I_UPA, I_UPB, I_UPC, I_WOUT, I_F2N, I_F2W1, I_F2W3, I_F2W2, I_FINN };

__device__ __forceinline__ const float* inp(int i) {
    const __attribute__((address_space(4))) char* kp = (const __attribute__((address_space(4))) char*)__builtin_amdgcn_kernarg_segment_ptr();
    unsigned off = (unsigned)i * 8u; asm volatile("" : "+s"(off));
    const float* g = *(const float* const __attribute__((address_space(4)))*)(kp + off);
    return (const float*)(const __attribute__((address_space(1))) float*)g;
}
__device__ __forceinline__ float wave_sum(float v) {
#pragma unroll
    for (int o = 1; o < 64; o <<= 1) v += __shfl_xor(v, o);
    return v;
}
__device__ __forceinline__ f32x4 mfma16(bf16x8 a, bf16x8 b, f32x4 c) { return __builtin_amdgcn_mfma_f32_16x16x32_bf16(a, b, c, 0, 0, 0); }

#define XB_TMO      128
#define XB_XCNT(j)  (256  + 64 * (j))
#define XB_XSUB(j)  (1280 + 64 * (j))
#define XB_XGEN(j)  (2304 + 64 * (j))
#define XB_TOP      3328
#define XB_TOPGEN   3392
#define XCD_BAR_WORDS 3456
#define XB_SPIN_CAP (1u << 22)

__device__ __forceinline__ unsigned xb_ld(unsigned* p)              { return __hip_atomic_load(p, __ATOMIC_RELAXED, __HIP_MEMORY_SCOPE_AGENT); }
__device__ __forceinline__ unsigned xb_add(unsigned* p, unsigned v) { return __hip_atomic_fetch_add(p, v, __ATOMIC_RELAXED, __HIP_MEMORY_SCOPE_AGENT); }
__device__ __forceinline__ unsigned xb_xcc_id() { return (unsigned)__builtin_amdgcn_s_getreg((3 << 11) | 20) & 0xFu; }
#define XB_SPIN(cond, bar) do { unsigned _sp = 0; while (cond) { __builtin_amdgcn_s_sleep(1); \
    if ((++_sp & 255u) == 0u) { if (xb_ld(&(bar)[XB_TMO])) break; if (_sp > XB_SPIN_CAP) { atomicAdd(&(bar)[XB_TMO], 1u); break; } } } } while (0)

struct XcdBarrier {
    unsigned* bar; unsigned x;
    volatile LAS unsigned* st;
};

__device__ __forceinline__ XcdBarrier xcd_barrier_post(unsigned* bar, volatile LAS unsigned* st) {
    XcdBarrier b; b.bar = bar; b.x = xb_xcc_id(); b.st = st;
    if (threadIdx.x == 0) (void)xb_add(&bar[XB_XCNT(b.x)], 1u);
    return b;
}
__device__ __forceinline__ void xcd_barrier_complete(unsigned* bar, unsigned x, unsigned& nloc, unsigned& nx) {
    const unsigned G = gridDim.x * gridDim.y * gridDim.z;
    unsigned sum, cnt, mine, sp = 0u;
    for (;;) {
        sum = 0u; cnt = 0u; mine = 0u;
#pragma unroll
        for (unsigned j = 0; j < 16; ++j) { const unsigned c = xb_ld(&bar[XB_XCNT(j)]); sum += c; cnt += (c > 0u) ? 1u : 0u; mine = (j == x) ? c : mine; }
        if (sum == G) break;
        __builtin_amdgcn_s_sleep(1);
        if ((++sp & 255u) == 0u) { if (xb_ld(&bar[XB_TMO])) break; if (sp > XB_SPIN_CAP) { atomicAdd(&bar[XB_TMO], 1u); break; } }
    }
    nloc = mine > 0u ? mine : 1u; nx = cnt > 0u ? cnt : 1u;
}

__device__ __forceinline__ void xcd_barrier(const XcdBarrier& b) {
    asm volatile("s_waitcnt vmcnt(0)" ::: "memory");
    __syncthreads();
    if (threadIdx.x == 0) {
        unsigned* bar = b.bar;
        __builtin_amdgcn_s_waitcnt(0);
        unsigned nloc = b.st[0], nx = b.st[1];
        if (nloc == 0u) { xcd_barrier_complete(bar, b.x, nloc, nx); b.st[0] = nloc; b.st[1] = nx; }
        const unsigned old = xb_add(&bar[XB_XSUB(b.x)], 1u);
        const unsigned gen = old / nloc;
        if (old + 1u == (gen + 1u) * nloc) {
            __builtin_amdgcn_fence(__ATOMIC_RELEASE, "agent");
            asm volatile("s_waitcnt vmcnt(0)" ::: "memory");
            const unsigned og = xb_add(&bar[XB_TOP], 1u);
            const unsigned tg = og / nx;
            if (og + 1u == (tg + 1u) * nx) xb_add(&bar[XB_TOPGEN], 1u);
            else XB_SPIN(xb_ld(&bar[XB_TOPGEN]) == tg, bar);
            __builtin_amdgcn_fence(__ATOMIC_ACQUIRE, "agent");
            xb_add(&bar[XB_XGEN(b.x)], 1u);
            asm volatile("s_waitcnt vmcnt(0)" ::: "memory");
        } else {
            XB_SPIN(xb_ld(&bar[XB_XGEN(b.x)]) == gen, bar);
            __builtin_amdgcn_fence(__ATOMIC_ACQUIRE, "agent");
            asm volatile("s_waitcnt vmcnt(0)" ::: "memory");
        }
    }
    __syncthreads();
}

template <class RowF>
__device__ __forceinline__ void tr_item(const float* src, int ldn, int nsrc, const float* gk, bf16_t* WT, int K, int item, int nblk, LAS float* scr, int lane, RowF rowmap) {
    const int kb = item / nblk, nb = item % nblk, k0 = 64 * kb, n0 = 32 * nb;
    const int ncol = n0 + (lane & 31); const bool okc = ncol < nsrc; const float* cp = src + (okc ? ncol : 0);
#pragma unroll 8
    for (int i = 0; i < 32; ++i) { const int kk = 2 * i + (lane >> 5); float v = okc ? cp[(size_t)(k0 + kk) * ldn] : 0.f; if (gk) v *= gk[k0 + kk]; scr[kk * 33 + (lane & 31)] = v; }
    asm volatile("s_waitcnt lgkmcnt(0)" ::: "memory");
    const int c = lane & 7;
#pragma unroll
    for (int j = 0; j < 4; ++j) { const int n = (lane >> 3) + 8 * j; const LAS float* s = scr + (8 * c) * 33 + n;
        u32x4 o; o.x = cvt_pk_bf16(s[0 * 33], s[1 * 33]); o.y = cvt_pk_bf16(s[2 * 33], s[3 * 33]); o.z = cvt_pk_bf16(s[4 * 33], s[5 * 33]); o.w = cvt_pk_bf16(s[6 * 33], s[7 * 33]);
        if (n0 + n < nsrc) *(u32x4*)(WT + (size_t)rowmap(n0 + n) * K + k0 + 8 * c) = o; }
    asm volatile("s_waitcnt lgkmcnt(0)" ::: "memory");
}
__device__ __forceinline__ int rm_id(int n) { return n; }
constexpr int PN1 = 16 * 88, PN2 = 44 * 32, PNIN = 16 * 278, PNLR = 6 * 8, PNC1 = 32 * 8, PNC2 = 4 * 2, PNUA = 12 * 32, PNUC = 4 * 32, PNWO = 16 * 32;
constexpr int PREP_GA = 2 * PN1 + PN2 + PNIN, PREP_GB = 2 * PNLR + 2 * PNC1 + 2 * PNC2 + 16 * 8 + 8, PREP_GC = 2 * PNUA + PNUC + PNWO + 2 * PN1 + PN2;
constexpr int PREP_GA_B = (PREP_GA + 7) / 8, PREP_GB_B = (PREP_GB + 7) / 8, PREP_GC_B = (PREP_GC + 7) / 8;
__device__ __forceinline__ void prep_wave_item(unsigned char* ws, int l, int grp, int r, LAS float* scr, int lane) {
    unsigned char* wt = ws + WS_WT;
    auto rm13a = [](int j) { return (j >> 2) * 8 + (j & 3); };
    auto rm13b = [](int j) { return (j >> 2) * 8 + 4 + (j & 3); };
    auto rmin = [](int o) { return o < 2304 ? o : o < 3456 ? o - 2304 + 7680 : o < 3492 ? o - 3456 + 8832 : o < 5796 ? o - 3492 + 2304 : o - 5796 + 4608; };
    if (grp == 0) {
        if (r < PN1) { tr_item(inp(I_F1W1) + (size_t)l * DM * DFF, DFF, DFF, inp(I_F1N) + l * DM, (bf16_t*)(wt + WT_W13A), 1024, r, 88, scr, lane, rm13a); return; } r -= PN1;
        if (r < PN1) { tr_item(inp(I_F1W3) + (size_t)l * DM * DFF, DFF, DFF, inp(I_F1N) + l * DM, (bf16_t*)(wt + WT_W13A), 1024, r, 88, scr, lane, rm13b); return; } r -= PN1;
        if (r < PN2) { tr_item(inp(I_F1W2) + (size_t)l * DFF * DM, DM, DM, nullptr, (bf16_t*)(wt + WT_W2A), 2816, r, 32, scr, lane, rm_id); return; } r -= PN2;
        if (r < PNIN) { tr_item(inp(I_WIN) + (size_t)l * DM * 8868, 8868, 8868, inp(I_MIXN) + l * DM, (bf16_t*)(wt + WT_WIN), 1024, r, 278, scr, lane, rmin); }
    } else if (grp == 1) {
        if (r < PNLR) { const int b = r / 8, rr = r % 8; tr_item(inp(I_LRUWA) + (size_t)l * 98304 + b * 16384, 128, 128, nullptr, (bf16_t*)(wt + WT_LRU) + b * 256 * 128, 128, rr, 4, scr, lane, rm_id); return; } r -= PNLR;
        if (r < PNLR) { const int b = r / 8, rr = r % 8; tr_item(inp(I_LRUWI) + (size_t)l * 98304 + b * 16384, 128, 128, nullptr, (bf16_t*)(wt + WT_LRU) + b * 256 * 128 + 128 * 128, 128, rr, 4, scr, lane, rm_id); return; } r -= PNLR;
        if (r < PNC1) { tr_item(inp(I_CK1) + (size_t)l * 2048 * 256, 256, 256, nullptr, (bf16_t*)(wt + WT_C1K), 2048, r, 8, scr, lane, rm_id); return; } r -= PNC1;
        if (r < PNC1) { tr_item(inp(I_CV1) + (size_t)l * 2048 * 256, 256, 256, nullptr, (bf16_t*)(wt + WT_C1V), 2048, r, 8, scr, lane, rm_id); return; } r -= PNC1;
        if (r < PNC2) { tr_item(inp(I_CK2) + (size_t)l * 256 * 64, 64, 64, nullptr, (bf16_t*)(wt + WT_C2K), 256, r, 2, scr, lane, rm_id); return; } r -= PNC2;
        if (r < PNC2) { tr_item(inp(I_CV2) + (size_t)l * 256 * 64, 64, 64, nullptr, (bf16_t*)(wt + WT_C2V), 256, r, 2, scr, lane, rm_id); return; } r -= PNC2;
        if (r < 128) {
            const int pb = r >> 3, wv = r & 7, kv = pb >> 3, part = pb & 7;
            if (lane < 32) { const int j = wv * 32 + lane;
                const float* pos = inp(kv ? I_POSV : I_POSK) + (size_t)l * 2048 + part * 256; const float* w1 = inp(kv ? I_CV1 : I_CK1) + (size_t)l * 2048 * 256 + (size_t)part * 256 * 256 + j;
                float s = 0.f;
#pragma unroll 8
                for (int kk = 0; kk < 256; ++kk) s += pos[kk] * w1[(size_t)kk * 256];
                ((float*)(ws + WS_BIASP))[pb * 256 + j] = s; }
            return; } r -= 128;
        if (r < 8) {
            u32x4* z = (u32x4*)((bf16_t*)(wt + WT_WIN) + (size_t)8868 * 1024); const int nz = 92 * 1024 * 2 / 16;
            unsigned zz = 0u; asm volatile("" : "+v"(zz));
            for (int i = r * 64 + lane; i < nz; i += 512) z[i] = (u32x4){zz, zz, zz, zz}; }
    } else {
        if (r < PNUA) { tr_item(inp(I_UPA) + (size_t)l * 768 * 1024, 1024, 1024, nullptr, (bf16_t*)(wt + WT_UA), 768, r, 32, scr, lane, rm_id); return; } r -= PNUA;
        if (r < PNUA) { tr_item(inp(I_UPB) + (size_t)l * 768 * 1024, 1024, 1024, nullptr, (bf16_t*)(wt + WT_UB), 768, r, 32, scr, lane, rm_id); return; } r -= PNUA;
        if (r < PNUC) { tr_item(inp(I_UPC) + (size_t)l * 256 * 1024, 1024, 1024, nullptr, (bf16_t*)(wt + WT_UC), 256, r, 32, scr, lane, rm_id); return; } r -= PNUC;
        if (r < PNWO) { tr_item(inp(I_WOUT) + (size_t)l * 1024 * 1024, 1024, 1024, nullptr, (bf16_t*)(wt + WT_WO), 1024, r, 32, scr, lane, rm_id); return; } r -= PNWO;
        if (r < PN1) { tr_item(inp(I_F2W1) + (size_t)l * DM * DFF, DFF, DFF, inp(I_F2N) + l * DM, (bf16_t*)(wt + WT_W13B), 1024, r, 88, scr, lane, rm13a); return; } r -= PN1;
        if (r < PN1) { tr_item(inp(I_F2W3) + (size_t)l * DM * DFF, DFF, DFF, inp(I_F2N) + l * DM, (bf16_t*)(wt + WT_W13B), 1024, r, 88, scr, lane, rm13b); return; } r -= PN1;
        if (r < PN2) { tr_item(inp(I_F2W2) + (size_t)l * DFF * DM, DM, DM, nullptr, (bf16_t*)(wt + WT_W2B), 2816, r, 32, scr, lane, rm_id); }
    }
}
__device__ __forceinline__ void prep_block_item(unsigned char* ws, int l, int grp, int bitem, ldsp lds, int tid) {
    asm volatile("" : "+v"(tid));
    const int lane = tid & 63, wave = __builtin_amdgcn_readfirstlane(tid >> 6);
    const int r = bitem * 8 + wave; const int cnt = grp == 0 ? PREP_GA : grp == 1 ? PREP_GB : PREP_GC;
    if (r < cnt) prep_wave_item(ws, l, grp, r, (LAS float*)(lds + wave * 8448), lane);
}
__device__ __forceinline__ void prep_phase(unsigned char* ws, int l, int grp, ldsp lds, int tid) {
    const int nb = grp == 0 ? PREP_GA_B : grp == 1 ? PREP_GB_B : PREP_GC_B;
    for (int b = blockIdx.x; b < nb; b += gridDim.x) prep_block_item(ws, l, grp, b, lds, tid);
}

struct FState { float m, l; f32x4 o[4]; };
__device__ __forceinline__ void fs_init(FState& st) { st.m = -1e30f; st.l = 0.f;
#pragma unroll
    for (int i = 0; i < 4; ++i) st.o[i] = (f32x4){0.f, 0.f, 0.f, 0.f}; }
constexpr int KV_BUF = 16384, NKVB = 3;
__device__ __forceinline__ int k_swz(int row) { return ((row >> 1) & 7) ^ (((row >> 4) & 1) << 1); }
struct KvOff { int k[2][2]; int v[2]; };
__device__ __forceinline__ KvOff kv_offsets(int c, int q) { KvOff o; const int rb = 8 * (c >> 2) + (c & 3);
#pragma unroll
    for (int b = 0; b < 2; ++b)
#pragma unroll
        for (int ks = 0; ks < 2; ++ks) { const int row = rb + 4 * b; o.k[ks][b] = row * 128 + (((ks * 4 + q) ^ k_swz(row)) * 16); }
#pragma unroll
    for (int k2 = 0; k2 < 2; ++k2) o.v[k2] = 8192 + c * 128 + (((4 * k2 + q) ^ ((c >> 1) & 7)) * 16);
    return o; }
__device__ __forceinline__ void qk_tile(ldsp B, const KvOff& ko, const bf16x8 (&qf)[2], f32x4 (&s)[4], f32x4 cinit) {
#pragma unroll
    for (int kt = 0; kt < 4; ++kt) { const bf16x8 a0 = *(const LAS bf16x8*)(B + ko.k[0][kt & 1] + (kt >> 1) * 4096), a1 = *(const LAS bf16x8*)(B + ko.k[1][kt & 1] + (kt >> 1) * 4096);
        s[kt] = mfma16(a0, qf[0], cinit); s[kt] = mfma16(a1, qf[1], s[kt]); }
}
#define KLOC(kt, r) (32 * ((kt) >> 1) + 4 * ((kt) & 1) + (r))
__device__ __forceinline__ void pv_tile(ldsp B, const KvOff& ko, const f32x4 (&p)[4], f32x4 (&o)[4], bool colok = true) {
#pragma unroll
    for (int k2 = 0; k2 < 2; ++k2) {
        u32x4 pw; pw.x = cvt_pk_bf16(p[2 * k2][0], p[2 * k2][1]); pw.y = cvt_pk_bf16(p[2 * k2][2], p[2 * k2][3]); pw.z = cvt_pk_bf16(p[2 * k2 + 1][0], p[2 * k2 + 1][1]); pw.w = cvt_pk_bf16(p[2 * k2 + 1][2], p[2 * k2 + 1][3]);
        pw.x = colok ? pw.x : 0u; pw.y = colok ? pw.y : 0u; pw.z = colok ? pw.z : 0u; pw.w = colok ? pw.w : 0u;
        const bf16x8 pb = __builtin_bit_cast(bf16x8, pw);
#pragma unroll
        for (int dt = 0; dt < 4; ++dt) o[dt] = mfma16(*(const LAS bf16x8*)(B + ko.v[k2] + dt * 2048), pb, o[dt]); }
}
__device__ __forceinline__ float quad_sum(float v) {
    v += __int_as_float(__builtin_amdgcn_update_dpp(0, __float_as_int(v), 0xB1, 0xF, 0xF, true));
    v += __int_as_float(__builtin_amdgcn_update_dpp(0, __float_as_int(v), 0x4E, 0xF, 0xF, true));
    return v; }
__device__ __forceinline__ float colmax4(float m) {
    { const auto rr = __builtin_amdgcn_permlane16_swap(__float_as_uint(m), __float_as_uint(m), false, false); m = fmaxf(__uint_as_float(rr[0]), __uint_as_float(rr[1])); }
    { const auto rr = __builtin_amdgcn_permlane32_swap(__float_as_uint(m), __float_as_uint(m), false, false); m = fmaxf(__uint_as_float(rr[0]), __uint_as_float(rr[1])); }
    return m;
}
template <int MK, class MaskF>
__device__ __forceinline__ void flash_step(ldsp B, const KvOff& ko, const bf16x8 (&qf)[2], FState& st, bool colok, MaskF mk) {
    const bool fresh = st.m <= -1e29f; const float mu = fresh ? 0.f : st.m;
    const f32x4 negm = (f32x4){-mu, -mu, -mu, -mu};
    f32x4 s[4]; qk_tile(B, ko, qf, s, negm);
    if (MK == 1) {
#pragma unroll
        for (int kt = 0; kt < 4; ++kt)
#pragma unroll
            for (int r = 0; r < 4; ++r) s[kt][r] = mk(KLOC(kt, r)) ? s[kt][r] : -1e30f; }
    float mx = fmaxf(fmaxf(s[0][0], s[0][1]), fmaxf(s[0][2], s[0][3]));
#pragma unroll
    for (int kt = 1; kt < 4; ++kt) mx = fmaxf(fmaxf(mx, s[kt][0]), fmaxf(fmaxf(s[kt][1], s[kt][2]), s[kt][3]));
    if (MK == 2) mx = colok ? mx : -1e30f;
    const bool need = fresh ? (mx > -1e29f) : (mx > 8.0f);
    if (__any(need)) {
        const float mc = colmax4(mx);
        const bool none = fresh && mc <= -1e29f;
        const float delta = none ? 0.f : (fresh ? mc : fmaxf(mc, 0.f));
        st.m = none ? st.m : mu + delta;
        const float alpha = __builtin_amdgcn_exp2f(-delta); st.l *= alpha;
#pragma unroll
        for (int dt = 0; dt < 4; ++dt) st.o[dt] = st.o[dt] * alpha;
#pragma unroll
        for (int kt = 0; kt < 4; ++kt) s[kt] = s[kt] - delta;
    }
    float rs = 0.f;
#pragma unroll
    for (int kt = 0; kt < 4; ++kt)
#pragma unroll
        for (int r = 0; r < 4; ++r) s[kt][r] = __builtin_amdgcn_exp2f(s[kt][r]);
#pragma unroll
    for (int kt = 0; kt < 4; ++kt) rs += (s[kt][0] + s[kt][1]) + (s[kt][2] + s[kt][3]);
    st.l += (MK == 2 && !colok) ? 0.f : rs;
    pv_tile(B, ko, s, st.o, (MK == 2) ? colok : true);
}
__device__ __forceinline__ void glds16(const void* gsrc, unsigned lds_dst) { unsigned keep;
    asm volatile("s_mov_b32 %0, m0\n\ts_mov_b32 m0, %2\n\ts_nop 0\n\tglobal_load_lds_dwordx4 %1, off\n\ts_mov_b32 m0, %0" : "=&s"(keep) : "v"(gsrc), "s"(lds_dst) : "memory"); }
template <class BodyF>
__device__ __forceinline__ void kv_loop(ldsp lds, const bf16_t* Kg, size_t kpitch, int kmaxrow, const bf16_t* VTg, size_t vtpitch, int kb0, int kb1, int tid, BodyF body) {
    asm volatile("" : "+v"(tid));
    const int r = tid >> 3, sc = (tid & 7) ^ ((r >> 1) & 7), sck = (tid & 7) ^ k_swz(r);
    const unsigned ldsw = (unsigned)__builtin_amdgcn_readfirstlane((int)(unsigned)(unsigned long long)lds + (tid >> 6) * 1024);
    const bf16_t* vsrc = VTg + (size_t)r * vtpitch + sc * 8;
    auto issue = [&](int kb, unsigned slot) { int row = kb * 64 + r; row = row < kmaxrow ? row : kmaxrow;
        glds16(Kg + (size_t)row * kpitch + sck * 8, ldsw + slot); glds16(vsrc + kb * 64, ldsw + slot + 8192); };
    if (kb0 < kb1) issue(kb0, 0u);
    if (kb0 + 1 < kb1) issue(kb0 + 1, (unsigned)KV_BUF);
    unsigned cs = 0u, ns = 2u * KV_BUF;
    for (int kb = kb0; kb < kb1; ++kb) {
        if (kb + 1 < kb1) asm volatile("s_waitcnt vmcnt(2) lgkmcnt(0)\n\ts_barrier" ::: "memory");
        else asm volatile("s_waitcnt vmcnt(0) lgkmcnt(0)\n\ts_barrier" ::: "memory");
        if (kb + 2 < kb1) issue(kb + 2, ns);
        body(kb, lds + cs);
        cs = cs == 2u * KV_BUF ? 0u : cs + KV_BUF; ns = ns == 2u * KV_BUF ? 0u : ns + KV_BUF;
    }
    asm volatile("s_waitcnt vmcnt(0) lgkmcnt(0)\n\ts_barrier" ::: "memory");
}
template <int CH, class BodyF>
__device__ __forceinline__ void kv_loop_chunked(ldsp lds, const bf16_t* Kg, size_t kpitch, int kmaxrow, const bf16_t* VTg, size_t vtpitch, int kb0, int kb1, int tid, BodyF body) {
    asm volatile("" : "+v"(tid));
    const int r = tid >> 3, sc = (tid & 7) ^ ((r >> 1) & 7);
    const unsigned ldsw = (unsigned)__builtin_amdgcn_readfirstlane((int)(unsigned)(unsigned long long)lds + (tid >> 6) * 1024);
    const bf16_t* vsrc = VTg + (size_t)r * vtpitch + sc * 8;
    auto issue_chunk = [&](int kbc, unsigned half) {
#pragma unroll
        for (int j = 0; j < CH; ++j) { const int kb = kbc + j; if (kb < kb1) { int row = kb * 64 + r; row = row < kmaxrow ? row : kmaxrow; const unsigned slot = half + (unsigned)j * KV_BUF;
            glds16(Kg + (size_t)row * kpitch + sc * 8, ldsw + slot); glds16(vsrc + kb * 64, ldsw + slot + 8192); } } };
    if (kb0 < kb1) issue_chunk(kb0, 0u);
    unsigned half = 0u;
    for (int kbc = kb0; kbc < kb1; kbc += CH) {
        asm volatile("s_waitcnt vmcnt(0) lgkmcnt(0)\n\ts_barrier" ::: "memory");
        if (kbc + CH < kb1) issue_chunk(kbc + CH, half ^ (unsigned)(CH * KV_BUF));
#pragma unroll 1
        for (int j = 0; j < CH; ++j) { const int kb = kbc + j; if (kb < kb1) body(kb, lds + half + j * KV_BUF); }
        half ^= (unsigned)(CH * KV_BUF);
    }
    asm volatile("s_waitcnt vmcnt(0) lgkmcnt(0)\n\ts_barrier" ::: "memory");
}
__device__ __forceinline__ float fs_ltot(const FState& st) { float l = st.l; l += __shfl_xor(l, 16); l += __shfl_xor(l, 32); return l; }

constexpr int NG = 2;
template <int MODE>
__device__ __forceinline__ void nsa_item(unsigned char* ws, ldsp lds, int tile, int kh, int tid) {
    asm volatile("" : "+v"(tid));
    const int lane = tid & 63, wave = __builtin_amdgcn_readfirstlane(tid >> 6), c = lane & 15, q = lane >> 4;
    const int t0 = tile * 64, tk = c >> 2, g = c & 3, hq = kh * 4 + g, cur = tile;
    const bf16_t* P = (const bf16_t*)(ws + WS_P);
    LAS float* imp = (LAS float*)(lds + NKVB * KV_BUF) + wave * (NG * 4 * 256);
    LAS unsigned* selm = (LAS unsigned*)(lds + 8 * KV_BUF) + wave * (NG * 4 * 8);
    const KvOff ko = kv_offsets(c, q);
    int t[NG]; bf16x8 qf[NG][2];
#pragma unroll
    for (int gi = 0; gi < NG; ++gi) { t[gi] = t0 + wave * (4 * NG) + gi * 4 + tk;
#pragma unroll
        for (int ks = 0; ks < 2; ++ks) qf[gi][ks] = *(const bf16x8*)(P + (size_t)t[gi] * PW + PC_BQ + hq * 64 + ks * 32 + q * 8); }
    const bf16_t* KC = (const bf16_t*)(ws + WS_KC) + (size_t)kh * 1024 * 64; const bf16_t* VCT = (const bf16_t*)(ws + WS_VCT) + (size_t)kh * 64 * 1024;
    const int nkbc = (t0 >> 10) + 1;
    float cm[NG], cl[NG];
#pragma unroll
    for (int gi = 0; gi < NG; ++gi) { cm[gi] = -1e30f; cl[gi] = 0.f; }
    if (MODE & 1) kv_loop(lds, KC, 64, 1023, VCT, 1024, 0, nkbc, tid, [&](int kb, ldsp B) {
#pragma unroll
        for (int gi = 0; gi < NG; ++gi) {
            f32x4 s[4]; qk_tile(B, ko, qf[gi], s, (f32x4){0.f, 0.f, 0.f, 0.f}); float mx = -1e30f; const int lim = ((t[gi] - 31) >> 4) - kb * 64 - 8 * q;
#pragma unroll
            for (int kt = 0; kt < 4; ++kt)
#pragma unroll
                for (int r = 0; r < 4; ++r) { const bool v = (KLOC(kt, r) <= lim); s[kt][r] = v ? s[kt][r] : -1e30f; mx = fmaxf(mx, s[kt][r]); }
            mx = colmax4(mx);
            const float mn = fmaxf(cm[gi], mx); const float alpha = __builtin_amdgcn_exp2f(cm[gi] - mn); cm[gi] = mn; float rs = 0.f;
#pragma unroll
            for (int kt = 0; kt < 4; ++kt)
#pragma unroll
                for (int r = 0; r < 4; ++r) rs += (s[kt][r] > -1e29f) ? __builtin_amdgcn_exp2f(s[kt][r] - mn) : 0.f;
            cl[gi] = cl[gi] * alpha + rs; }
    });
#pragma unroll
    for (int gi = 0; gi < NG; ++gi) { float lt = cl[gi]; lt += __shfl_xor(lt, 16); lt += __shfl_xor(lt, 32); cl[gi] = lt > 0.f ? 1.f / lt : 0.f; }
    {
    f32x4 fin[NG][4];
#pragma unroll
    for (int gi = 0; gi < NG; ++gi)
#pragma unroll
        for (int i = 0; i < 4; ++i) fin[gi][i] = (f32x4){0.f, 0.f, 0.f, 0.f};
    if (MODE & 1) kv_loop(lds, KC, 64, 1023, VCT, 1024, 0, nkbc, tid, [&](int kb, ldsp B) {
#pragma unroll
        for (int gi = 0; gi < NG; ++gi) {
            f32x4 s[4]; qk_tile(B, ko, qf[gi], s, (f32x4){0.f, 0.f, 0.f, 0.f}); const int lim = ((t[gi] - 31) >> 4) - kb * 64 - 8 * q;
#pragma unroll
            for (int kt = 0; kt < 4; ++kt) { float ps = 0.f;
#pragma unroll
                for (int r = 0; r < 4; ++r) { const bool v = (KLOC(kt, r) <= lim); const float p = v ? __builtin_amdgcn_exp2f(s[kt][r] - cm[gi]) * cl[gi] : 0.f; s[kt][r] = p; ps += p; }
                ps = quad_sum(ps);
                if (g == 0) imp[(gi * 4 + tk) * 256 + kb * 16 + 8 * (kt >> 1) + 2 * q + (kt & 1)] = ps; }
            pv_tile(B, ko, s, fin[gi]); }
    });
#pragma unroll
    for (int gi = 0; gi < NG; ++gi) { const float g0 = sigm(bflo((unsigned)P[(size_t)t[gi] * PW + PC_BG + hq * 3])); bf16_t* O = (bf16_t*)(ws + WS_NSAO) + (size_t)t[gi] * 768 + hq * 64;
#pragma unroll
        for (int dt = 0; dt < 4; ++dt) { const f32x4 v = fin[gi][dt] * g0; u32x2 w; w.x = cvt_pk_bf16(v[0], v[1]); w.y = cvt_pk_bf16(v[2], v[3]); if ((MODE & 16) || v[0] == 12345.678f) *(u32x2*)(O + dt * 16 + 4 * q) = w; } }
    }
    asm volatile("s_waitcnt lgkmcnt(0)" ::: "memory");
    if (MODE & 2)
#pragma unroll 2
    for (int tt = 0; tt < NG * 4; ++tt) {
        LAS float* im = imp + tt * 256;
        unsigned vb[4];
#pragma unroll
        for (int i = 0; i < 4; ++i) { const int n = lane + 64 * i; const float f = im[n]; vb[i] = (n <= cur) ? ((n == 0 || n == cur) ? 0x4e6e6b28u   : __float_as_uint(f)) : 0u; }
        unsigned long long selb[4];
        if (cur < 16) {
#pragma unroll
            for (int i = 0; i < 4; ++i) selb[i] = __ballot(lane + 64 * i <= cur);
        } else {
            unsigned thr = 0u; bool exact = false;
            for (int b = 30; b >= 0; --b) { const unsigned cand = thr | (1u << b); int cnt = 0;
#pragma unroll
                for (int i = 0; i < 4; ++i) cnt += __builtin_popcountll(__ballot(vb[i] >= cand));
                if (cnt >= 16) { thr = cand; if (cnt == 16) { exact = true; break; } } }
            if (exact) {
#pragma unroll
                for (int i = 0; i < 4; ++i) selb[i] = __ballot(vb[i] >= thr);
            } else {
            int ngt = 0;
#pragma unroll
            for (int i = 0; i < 4; ++i) ngt += __builtin_popcountll(__ballot(vb[i] > thr));
            int need = 16 - ngt;
#pragma unroll
            for (int i = 0; i < 4; ++i) { const unsigned long long eq = __ballot(vb[i] == thr && lane + 64 * i <= cur); const unsigned long long below = eq & ((1ull << lane) - 1ull);
                const bool take = (vb[i] == thr) && (lane + 64 * i <= cur) && ((int)__builtin_popcountll(below) < need);
                selb[i] = __ballot((vb[i] > thr) || take); need -= (int)__builtin_popcountll(eq); need = need < 0 ? 0 : need; }
            }
        }
#pragma unroll
        for (int i = 0; i < 4; ++i) if (lane == 0) { selm[tt * 8 + 2 * i] = (unsigned)selb[i]; selm[tt * 8 + 2 * i + 1] = (unsigned)(selb[i] >> 32); }
    }
    asm volatile("s_waitcnt lgkmcnt(0)" ::: "memory");
    if (MODE & 4) {
        LAS unsigned* sm_all = (LAS unsigned*)(lds + 8 * KV_BUF);
        ldsp QT = lds;
        LAS int* OACC = (LAS int*)(lds + 49152);
        LAS int* LACC = (LAS int*)(lds + 49152 + 256 * 272); LAS float* MREF = (LAS float*)(LACC + 256);
        const bf16_t* Kg = P + PC_KS + kh * 64; const bf16_t* VTg = (const bf16_t*)(ws + WS_VTS) + (size_t)kh * 64 * S;
        __syncthreads();
#pragma unroll
        for (int gi = 0; gi < NG; ++gi) { const int row = (wave * (4 * NG) + gi * 4 + tk) * 4 + g, sw = (row >> 1) & 7;
#pragma unroll
            for (int ks = 0; ks < 2; ++ks) *(LAS bf16x8*)(QT + row * 128 + (((ks * 4 + q) ^ sw) * 16)) = qf[gi][ks]; }
        for (int i = tid; i < 256 * 68 + 256; i += NT) OACC[i] = 0;
        __syncthreads();
        auto block_step = [&](int kb, const bf16x8 (&kf)[4][2], const u32x4 (&vf)[4][2], int rowv, bool colok, bool diag, int tq, bool setref) {
            const int sw = (rowv >> 1) & 7;
            const bf16x8 q0 = *(const LAS bf16x8*)(QT + rowv * 128 + ((q ^ sw) * 16)), q1 = *(const LAS bf16x8*)(QT + rowv * 128 + (((4 + q) ^ sw) * 16));
            const float cin = setref ? 0.f : 10.f - MREF[rowv];
            const f32x4 cinit = (f32x4){cin, cin, cin, cin};
            f32x4 s[4];
#pragma unroll
            for (int kt = 0; kt < 4; ++kt) { s[kt] = mfma16(kf[kt][0], q0, cinit); s[kt] = mfma16(kf[kt][1], q1, s[kt]); }
            if (diag) { const int lim = tq - kb * 64 - 8 * q;
#pragma unroll
                for (int kt = 0; kt < 4; ++kt)
#pragma unroll
                    for (int r = 0; r < 4; ++r) s[kt][r] = (32 * (kt >> 1) + 4 * (kt & 1) + r <= lim) ? s[kt][r] : -1e30f; }
            if (setref) { float mx = fmaxf(fmaxf(s[0][0], s[0][1]), fmaxf(s[0][2], s[0][3]));
#pragma unroll
                for (int kt = 1; kt < 4; ++kt) mx = fmaxf(fmaxf(mx, s[kt][0]), fmaxf(fmaxf(s[kt][1], s[kt][2]), s[kt][3]));
                const float mref = colmax4(mx); if (q == 0) MREF[rowv] = mref;
                const float d = mref - 10.f;
#pragma unroll
                for (int kt = 0; kt < 4; ++kt) s[kt] = s[kt] - d; }
            float rs = 0.f;
#pragma unroll
            for (int kt = 0; kt < 4; ++kt) {
#pragma unroll
                for (int r = 0; r < 4; ++r) s[kt][r] = __builtin_amdgcn_exp2f(s[kt][r]);
                rs += (s[kt][0] + s[kt][1]) + (s[kt][2] + s[kt][3]); }
            { const auto rr = __builtin_amdgcn_permlane16_swap(__float_as_uint(rs), __float_as_uint(rs), false, false); rs = __uint_as_float(rr[0]) + __uint_as_float(rr[1]); }
            { const auto rr = __builtin_amdgcn_permlane32_swap(__float_as_uint(rs), __float_as_uint(rs), false, false); rs = __uint_as_float(rr[0]) + __uint_as_float(rr[1]); }
            if (q == 0 && colok) __hip_atomic_fetch_add(LACC + rowv, __float2int_rn(rs), __ATOMIC_RELAXED, __HIP_MEMORY_SCOPE_WORKGROUP);
            f32x4 o[4];
#pragma unroll
            for (int dt = 0; dt < 4; ++dt) o[dt] = (f32x4){0.f, 0.f, 0.f, 0.f};
#pragma unroll
            for (int k2 = 0; k2 < 2; ++k2) { u32x4 pw; pw.x = cvt_pk_bf16(s[2 * k2][0], s[2 * k2][1]); pw.y = cvt_pk_bf16(s[2 * k2][2], s[2 * k2][3]); pw.z = cvt_pk_bf16(s[2 * k2 + 1][0], s[2 * k2 + 1][1]); pw.w = cvt_pk_bf16(s[2 * k2 + 1][2], s[2 * k2 + 1][3]);
                const bf16x8 pb = __builtin_bit_cast(bf16x8, pw);
#pragma unroll
                for (int dt = 0; dt < 4; ++dt) o[dt] = mfma16(__builtin_bit_cast(bf16x8, vf[dt][k2]), pb, o[dt]); }
            if (colok) {
#pragma unroll
                for (int dt = 0; dt < 4; ++dt)
#pragma unroll
                    for (int r = 0; r < 4; ++r) { if (MODE & 32) OACC[rowv * 68 + (dt * 4 + r) * 4 + q] = __float2int_rn(o[dt][r]); else __hip_atomic_fetch_add(OACC + rowv * 68 + (dt * 4 + r) * 4 + q, __float2int_rn(o[dt][r]), __ATOMIC_RELAXED, __HIP_MEMORY_SCOPE_WORKGROUP); } }
        };
        auto load_kv = [&](int kb, bf16x8 (&kf)[4][2], u32x4 (&vf)[4][2]) {
#pragma unroll
            for (int kt = 0; kt < 4; ++kt)
#pragma unroll
                for (int ks = 0; ks < 2; ++ks) kf[kt][ks] = *(const bf16x8*)(Kg + (size_t)(kb * 64 + 32 * (kt >> 1) + 8 * (c >> 2) + 4 * (kt & 1) + (c & 3)) * PW + ks * 32 + q * 8);
#pragma unroll
            for (int dt = 0; dt < 4; ++dt)
#pragma unroll
                for (int k2 = 0; k2 < 2; ++k2) vf[dt][k2] = *(const u32x4*)(VTg + (size_t)(dt * 16 + c) * S + kb * 64 + 32 * k2 + 8 * q); };
        { bf16x8 kf[4][2]; u32x4 vf[4][2];
            load_kv(cur, kf, vf);
#pragma unroll
            for (int gi = 0; gi < NG; ++gi) block_step(cur, kf, vf, (wave * (4 * NG) + gi * 4 + tk) * 4 + g, true, true, t[gi], true);
            if (cur > 0) { asm volatile("s_waitcnt lgkmcnt(0)" ::: "memory"); load_kv(0, kf, vf);
#pragma unroll
                for (int gi = 0; gi < NG; ++gi) block_step(0, kf, vf, (wave * (4 * NG) + gi * 4 + tk) * 4 + g, true, false, 0, false); } }
        __syncthreads();
        { auto process = [&](int kb, const bf16x8 (&kf)[4][2], const u32x4 (&vf)[4][2]) {
                const unsigned wsel = sm_all[lane * 8 + (kb >> 5)];
                unsigned long long mm = __ballot((wsel >> (kb & 31)) & 1u);
                while (mm != 0ull) { int tj[4]; int nt = 0;
#pragma unroll
                    for (int j = 0; j < 4; ++j) { const bool has = mm != 0ull; tj[j] = has ? (int)__builtin_ctzll(mm) : 0; nt += has ? 1 : 0; mm = has ? (mm & (mm - 1ull)) : 0ull; }
                    const int j = c >> 2; const int mytok = j == 0 ? tj[0] : j == 1 ? tj[1] : j == 2 ? tj[2] : tj[3];
                    block_step(kb, kf, vf, mytok * 4 + g, j < nt, false, 0, false); } };
            bf16x8 kfA[4][2], kfB[4][2]; u32x4 vfA[4][2], vfB[4][2];
            auto take4 = [&](unsigned long long& mm, int& rowv, bool& ok) { int tj[4]; int nt = 0;
#pragma unroll
                for (int j = 0; j < 4; ++j) { const bool has = mm != 0ull; tj[j] = has ? (int)__builtin_ctzll(mm) : 0; nt += has ? 1 : 0; mm = has ? (mm & (mm - 1ull)) : 0ull; }
                const int j = c >> 2; const int mytok = j == 0 ? tj[0] : j == 1 ? tj[1] : j == 2 ? tj[2] : tj[3]; rowv = mytok * 4 + g; ok = j < nt; };
            if (!(MODE & 64)) for (int kb = wave == 0 ? 8 : wave; kb < cur; kb += 16) {
                load_kv(kb, kfA, vfA);
                if (kb + 8 < cur) { load_kv(kb + 8, kfB, vfB);
                    unsigned long long mA = __ballot((sm_all[lane * 8 + (kb >> 5)] >> (kb & 31)) & 1u), mB = __ballot((sm_all[lane * 8 + ((kb + 8) >> 5)] >> ((kb + 8) & 31)) & 1u);
                    while (mA != 0ull && mB != 0ull) { int ra, rb; bool oa, ob; take4(mA, ra, oa); take4(mB, rb, ob);
                        block_step(kb, kfA, vfA, ra, oa, false, 0, false); block_step(kb + 8, kfB, vfB, rb, ob, false, 0, false); }
                    while (mA != 0ull) { int ra; bool oa; take4(mA, ra, oa); block_step(kb, kfA, vfA, ra, oa, false, 0, false); }
                    while (mB != 0ull) { int rb; bool ob; take4(mB, rb, ob); block_step(kb + 8, kfB, vfB, rb, ob, false, 0, false); }
                } else process(kb, kfA, vfA);
            } }
        __syncthreads();
#pragma unroll
        for (int gi = 0; gi < NG; ++gi) { const int row = (wave * (4 * NG) + gi * 4 + tk) * 4 + g; const float lt = (float)LACC[row]; const float gg = sigm(bflo((unsigned)P[(size_t)t[gi] * PW + PC_BG + hq * 3 + 1])); const float sc = lt > 0.f ? gg / lt : 0.f;
            bf16_t* O = (bf16_t*)(ws + WS_NSAO) + (size_t)t[gi] * 768 + hq * 64;
#pragma unroll
            for (int dt = 0; dt < 4; ++dt) { const u32x2 ov = *(const u32x2*)(O + dt * 16 + 4 * q); const LAS int* ip = OACC + row * 68 + dt * 16 + q; const f32x4 v = (f32x4){(float)ip[0], (float)ip[4], (float)ip[8], (float)ip[12]} * sc;
                u32x2 w; w.x = cvt_pk_bf16(bflo(ov.x) + v[0], bfhi(ov.x) + v[1]); w.y = cvt_pk_bf16(bflo(ov.y) + v[2], bfhi(ov.y) + v[3]); if ((MODE & 16) || v[0] == 12345.678f) *(u32x2*)(O + dt * 16 + 4 * q) = w; } }
        __syncthreads();
    }
    if (MODE & 8) {
        FState st[NG]; bf16x8 qw[NG][2];
#pragma unroll
        for (int gi = 0; gi < NG; ++gi) { fs_init(st[gi]);
#pragma unroll
            for (int ks = 0; ks < 2; ++ks) qw[gi][ks] = *(const bf16x8*)(P + (size_t)t[gi] * PW + PC_BQ + hq * 64 + ks * 32 + q * 8); }
        const int kb0 = (t0 - 511 > 0 ? t0 - 511 : 0) >> 6, kb1 = cur + 1;
        kv_loop(lds, P + PC_KW + kh * 64, PW, S - 1, (const bf16_t*)(ws + WS_VTW) + (size_t)kh * 64 * S, S, kb0, kb1, tid, [&](int kb, ldsp B) {
#pragma unroll
            for (int gi = 0; gi < NG; ++gi) { const int hi = t[gi] - kb * 64 - 8 * q, lo = hi - 511;
                if (kb > kb0 + 1 && kb < cur) flash_step<0>(B, ko, qw[gi], st[gi], true, [](int) { return true; });
                else flash_step<1>(B, ko, qw[gi], st[gi], true, [&](int kk) { return kk <= hi && kk >= lo; }); }
        });
#pragma unroll
        for (int gi = 0; gi < NG; ++gi) { const float lt = fs_ltot(st[gi]); const float gg = sigm(bflo((unsigned)P[(size_t)t[gi] * PW + PC_BG + hq * 3 + 2])); const float sc = lt > 0.f ? gg / lt : 0.f;
            bf16_t* O = (bf16_t*)(ws + WS_NSAO) + (size_t)t[gi] * 768 + hq * 64;
#pragma unroll
            for (int dt = 0; dt < 4; ++dt) { const u32x2 ov = *(const u32x2*)(O + dt * 16 + 4 * q); const f32x4 v = st[gi].o[dt] * sc;
                u32x2 w; w.x = cvt_pk_bf16(bflo(ov.x) + v[0], bfhi(ov.x) + v[1]); w.y = cvt_pk_bf16(bflo(ov.y) + v[2], bfhi(ov.y) + v[3]); if ((MODE & 16) || v[0] == 12345.678f) *(u32x2*)(O + dt * 16 + 4 * q) = w; } }
    }
}

__device__ __forceinline__ void dil_task(unsigned char* ws, int task, int lane) {
    const int c = lane & 15, q = lane >> 4;
    const int hh = task >> 10, u = task & 1023, gi = hh >> 2, dsh = 2 * gi  , Ls = S >> dsh, gpr = Ls >> 4  ;
    const int r = u / gpr, i0 = (u - r * gpr) * 16, ib = i0 - 128;
    bf16_t* P = (bf16_t*)(ws + WS_P);
    const int t = ((i0 + c) << dsh) + r;
    bf16x8 qf[2];
#pragma unroll
    for (int ks = 0; ks < 2; ++ks) qf[ks] = *(const bf16x8*)(P + (size_t)t * PW + PC_CQ + hh * 64 + ks * 32 + q * 8);
    f32x4 s[9];
#pragma unroll
    for (int kt = 0; kt < 9; ++kt) { int ik = ib + kt * 16 + c; ik = ik < 0 ? 0 : ik; const bf16_t* kp = P + (size_t)((ik << dsh) + r) * PW + PC_CK + hh * 64 + q * 8;
        const bf16x8 a0 = *(const bf16x8*)kp, a1 = *(const bf16x8*)(kp + 32);
        s[kt] = mfma16(a0, qf[0], (f32x4){0.f, 0.f, 0.f, 0.f}); s[kt] = mfma16(a1, qf[1], s[kt]); }
    const int base = 4 * q - 128 - c; float mx = -1e30f;
#pragma unroll
    for (int kt = 0; kt < 9; ++kt)
#pragma unroll
        for (int rr = 0; rr < 4; ++rr) { const int rel = base + kt * 16 + rr; const bool v = rel <= 0 && rel >= -128 && (ib + kt * 16 + 4 * q + rr) >= 0; s[kt][rr] = v ? s[kt][rr] : -1e30f; mx = fmaxf(mx, s[kt][rr]); }
    mx = colmax4(mx);
    float l = 0.f;
#pragma unroll
    for (int kt = 0; kt < 9; ++kt)
#pragma unroll
        for (int rr = 0; rr < 4; ++rr) { const float p = __builtin_amdgcn_exp2f(s[kt][rr] - mx); s[kt][rr] = p; l += p; }
    { float lt = l; lt += __shfl_xor(lt, 16); lt += __shfl_xor(lt, 32); l = lt; }
    const bf16_t* VT = (const bf16_t*)(ws + WS_VTC) + (size_t)hh * 64 * S + (size_t)r * Ls;
    f32x4 o[4];
#pragma unroll
    for (int dt = 0; dt < 4; ++dt) o[dt] = (f32x4){0.f, 0.f, 0.f, 0.f};
#pragma unroll
    for (int k2 = 0; k2 < 5; ++k2) {
        u32x4 pw; pw.x = cvt_pk_bf16(s[2 * k2][0], s[2 * k2][1]); pw.y = cvt_pk_bf16(s[2 * k2][2], s[2 * k2][3]);
        if (k2 < 4) { pw.z = cvt_pk_bf16(s[2 * k2 + 1][0], s[2 * k2 + 1][1]); pw.w = cvt_pk_bf16(s[2 * k2 + 1][2], s[2 * k2 + 1][3]); } else { pw.z = 0u; pw.w = 0u; }
        const bf16x8 pb = __builtin_bit_cast(bf16x8, pw);
        int c0 = ib + 32 * k2 + 4 * q; c0 = c0 < 0 ? 0 : c0; int c1 = ib + 32 * k2 + 16 + 4 * q; c1 = c1 < 0 ? 0 : c1; c1 = (k2 < 4) ? c1 : c0;
#pragma unroll
        for (int dt = 0; dt < 4; ++dt) { const bf16_t* vp = VT + (size_t)(dt * 16 + c) * S;
            const u32x2 lo = *(const u32x2*)(vp + c0), hi = *(const u32x2*)(vp + c1);
            u32x4 aw; aw.x = lo.x; aw.y = lo.y; aw.z = hi.x; aw.w = hi.y;
            o[dt] = mfma16(__builtin_bit_cast(bf16x8, aw), pb, o[dt]); } }
    const float il = 1.f / l;
    bf16_t* O = P + (size_t)t * PW + PC_AX + hh * 64;
#pragma unroll
    for (int dt = 0; dt < 4; ++dt) { const f32x4 v = o[dt] * il; u32x2 w; w.x = cvt_pk_bf16(v[0], v[1]); w.y = cvt_pk_bf16(v[2], v[3]); *(u32x2*)(O + dt * 16 + 4 * q) = w; }
    if (q == 0) ((float*)(ws + WS_LSE))[(size_t)hh * S + t] = mx + __builtin_amdgcn_logf(l);
}
__device__ __forceinline__ void dil_combine(unsigned char* ws, int tid) {
    const bf16_t* P = (const bf16_t*)(ws + WS_P); const float* LSE = (const float*)(ws + WS_LSE); bf16_t* DO = (bf16_t*)(ws + WS_DILO);
    for (int i = blockIdx.x * NT + tid; i < S * 32; i += gridDim.x * NT) { const int t = i >> 5, j = (i >> 3) & 3, ch = i & 7;
        const float l0 = LSE[(size_t)j * S + t], l1 = LSE[(size_t)(4 + j) * S + t], l2 = LSE[(size_t)(8 + j) * S + t];
        const float m = fmaxf(l0, fmaxf(l1, l2)); float w0 = __builtin_amdgcn_exp2f(l0 - m), w1 = __builtin_amdgcn_exp2f(l1 - m), w2 = __builtin_amdgcn_exp2f(l2 - m);
        const float inv = 1.f / (w0 + w1 + w2); w0 *= inv; w1 *= inv; w2 *= inv;
        const bf16_t* pr = P + (size_t)t * PW + PC_AX + j * 64 + ch * 8;
        const u32x4 a = *(const u32x4*)pr, b = *(const u32x4*)(pr + 256), cc = *(const u32x4*)(pr + 512);
        u32x4 o; o.x = cvt_pk_bf16(w0 * bflo(a.x) + w1 * bflo(b.x) + w2 * bflo(cc.x), w0 * bfhi(a.x) + w1 * bfhi(b.x) + w2 * bfhi(cc.x));
        o.y = cvt_pk_bf16(w0 * bflo(a.y) + w1 * bflo(b.y) + w2 * bflo(cc.y), w0 * bfhi(a.y) + w1 * bfhi(b.y) + w2 * bfhi(cc.y));
        o.z = cvt_pk_bf16(w0 * bflo(a.z) + w1 * bflo(b.z) + w2 * bflo(cc.z), w0 * bfhi(a.z) + w1 * bfhi(b.z) + w2 * bfhi(cc.z));
        o.w = cvt_pk_bf16(w0 * bflo(a.w) + w1 * bflo(b.w) + w2 * bflo(cc.w), w0 * bfhi(a.w) + w1 * bfhi(b.w) + w2 * bfhi(cc.w));
        *(u32x4*)(DO + (size_t)t * 256 + j * 64 + ch * 8) = o; }
}
__device__ __forceinline__ void cmp_item(unsigned char* ws, ldsp lds, int it, int tid) {
    asm volatile("" : "+v"(tid));
    const int lane = tid & 63, wave = __builtin_amdgcn_readfirstlane(tid >> 6), c = lane & 15, q = lane >> 4;
    const int kv = it / 96, rem = it % 96, h = rem / 32, c0 = (rem % 32) * 32;
    const bf16_t* P = (const bf16_t*)(ws + WS_P) + (kv ? PC_VC : PC_KC) + h * 64;
    for (int idx = tid; idx < 528 * 8; idx += NT) { const int tl = idx >> 3, ch = idx & 7; int tok = 16 * c0 + tl; tok = tok < S ? tok : S - 1;
        const u32x4 v = *(const u32x4*)(P + (size_t)tok * PW + ch * 8);
        *(LAS u32x4*)(lds + ((tl & 15) * 34 + (tl >> 4)) * 144 + ch * 16) = v; }
    __syncthreads();
    const bf16_t* W1t = (const bf16_t*)(ws + WS_WT + (kv ? WT_C1V : WT_C1K));
    f32x4 acc[2][2];
#pragma unroll
    for (int i = 0; i < 2; ++i)
#pragma unroll
        for (int j = 0; j < 2; ++j) acc[i][j] = (f32x4){0.f, 0.f, 0.f, 0.f};
    const bf16_t* wp0 = W1t + (size_t)((2 * wave) * 16 + c) * 2048 + 8 * q; const bf16_t* wp1 = wp0 + (size_t)16 * 2048;
#pragma unroll 8
    for (int ks = 0; ks < 64; ++ks) { const int l_ = ks >> 1, d0 = (ks & 1) * 32;
        const bf16x8 b0 = *(const bf16x8*)(wp0 + ks * 32), b1 = *(const bf16x8*)(wp1 + ks * 32);
        ldsp ap = lds + ((l_ & 15) * 34 + c + (l_ >> 4)) * 144 + (d0 + 8 * q) * 2;
        const bf16x8 a0 = *(const LAS bf16x8*)(ap), a1 = *(const LAS bf16x8*)(ap + 16 * 144);
        acc[0][0] = mfma16(a0, b0, acc[0][0]); acc[0][1] = mfma16(a0, b1, acc[0][1]); acc[1][0] = mfma16(a1, b0, acc[1][0]); acc[1][1] = mfma16(a1, b1, acc[1][1]); }
    LAS bf16_t* Hs = (LAS bf16_t*)(lds + 78336);
    const float* bp = (const float*)(ws + WS_BIASP) + kv * 8 * 256;
#pragma unroll
    for (int nl = 0; nl < 2; ++nl) { const int n = (2 * wave + nl) * 16 + c; float b = 0.f;
#pragma unroll
        for (int p = 0; p < 8; ++p) b += bp[p * 256 + n];
#pragma unroll
        for (int mt = 0; mt < 2; ++mt)
#pragma unroll
            for (int r = 0; r < 4; ++r) { const float v = gelu_t(acc[mt][nl][r] + b); Hs[(mt * 16 + 4 * q + r) * 264 + n] = (bf16_t)(cvt_pk_bf16(v, v) & 0xffffu); } }
    __syncthreads();
    const bf16_t* W2t = (const bf16_t*)(ws + WS_WT + (kv ? WT_C2V : WT_C2K));
    const int mt = wave >> 2, nt = wave & 3;
    f32x4 a2 = (f32x4){0.f, 0.f, 0.f, 0.f};
#pragma unroll
    for (int ks = 0; ks < 8; ++ks) { const bf16x8 av = *(const LAS bf16x8*)((ldsp)Hs + ((mt * 16 + c) * 264 + ks * 32 + 8 * q) * 2);
        const bf16x8 bv = *(const bf16x8*)(W2t + (size_t)(nt * 16 + c) * 256 + ks * 32 + 8 * q); a2 = mfma16(av, bv, a2); }
    if (kv == 0) { bf16_t* KC = (bf16_t*)(ws + WS_KC) + (size_t)h * 1024 * 64;
#pragma unroll
        for (int r = 0; r < 4; ++r) KC[(size_t)(c0 + mt * 16 + 4 * q + r) * 64 + nt * 16 + c] = (bf16_t)(cvt_pk_bf16(a2[r], a2[r]) & 0xffffu); }
    else { bf16_t* VCT = (bf16_t*)(ws + WS_VCT) + (size_t)h * 64 * 1024; u32x2 w; w.x = cvt_pk_bf16(a2[0], a2[1]); w.y = cvt_pk_bf16(a2[2], a2[3]);
        *(u32x2*)(VCT + (size_t)(nt * 16 + c) * 1024 + c0 + mt * 16 + 4 * q) = w; }
    __syncthreads();
}

__device__ __forceinline__ void lru_tile_item(unsigned char* ws, ldsp lds, int it, int l, int tid) {
    asm volatile("" : "+v"(tid));
    const int lane = tid & 63, wave = __builtin_amdgcn_readfirstlane(tid >> 6), c = lane & 15, q = lane >> 4;
    const int ci = it / 6, b = it % 6, t0 = ci * 64, ch0 = b * 128;
    const bf16_t* P = (const bf16_t*)(ws + WS_P);
    { const int tok = tid >> 3, cg = (tid & 7) * 16; float xc[16];
        const float* cb = inp(I_CONVB) + l * 768 + ch0 + cg; const float* cw = inp(I_CONVW) + (size_t)l * 4 * 768 + ch0 + cg;
#pragma unroll
        for (int i = 0; i < 16; ++i) xc[i] = cb[i];
#pragma unroll
        for (int j = 0; j < 4; ++j) { const int tt = t0 + tok - 3 + j;
            if (tt >= 0) { const u32x4 v0 = *(const u32x4*)(P + (size_t)tt * PW + PC_AX + ch0 + cg), v1 = *(const u32x4*)(P + (size_t)tt * PW + PC_AX + ch0 + cg + 8);
                const float x[16] = {bflo(v0.x), bfhi(v0.x), bflo(v0.y), bfhi(v0.y), bflo(v0.z), bfhi(v0.z), bflo(v0.w), bfhi(v0.w), bflo(v1.x), bfhi(v1.x), bflo(v1.y), bfhi(v1.y), bflo(v1.z), bfhi(v1.z), bflo(v1.w), bfhi(v1.w)};
#pragma unroll
                for (int i = 0; i < 16; ++i) xc[i] += cw[j * 768 + i] * x[i]; } }
        u32x4 w0, w1; w0.x = cvt_pk_bf16(xc[0], xc[1]); w0.y = cvt_pk_bf16(xc[2], xc[3]); w0.z = cvt_pk_bf16(xc[4], xc[5]); w0.w = cvt_pk_bf16(xc[6], xc[7]);
        w1.x = cvt_pk_bf16(xc[8], xc[9]); w1.y = cvt_pk_bf16(xc[10], xc[11]); w1.z = cvt_pk_bf16(xc[12], xc[13]); w1.w = cvt_pk_bf16(xc[14], xc[15]);
        *(LAS u32x4*)(lds + tok * 272 + cg * 2) = w0; *(LAS u32x4*)(lds + tok * 272 + cg * 2 + 16) = w1; }
    __syncthreads();
    const bf16_t* Wl = (const bf16_t*)(ws + WS_WT + WT_LRU) + (size_t)b * 256 * 128;
    f32x4 acc[2][4];
#pragma unroll
    for (int i = 0; i < 2; ++i)
#pragma unroll
        for (int j = 0; j < 4; ++j) acc[i][j] = (f32x4){0.f, 0.f, 0.f, 0.f};
#pragma unroll
    for (int ks = 0; ks < 4; ++ks) { const bf16x8 b0 = *(const bf16x8*)(Wl + (size_t)(wave * 16 + c) * 128 + ks * 32 + 8 * q), b1 = *(const bf16x8*)(Wl + (size_t)(128 + wave * 16 + c) * 128 + ks * 32 + 8 * q);
#pragma unroll
        for (int mt = 0; mt < 4; ++mt) { const bf16x8 av = *(const LAS bf16x8*)(lds + (mt * 16 + c) * 272 + (ks * 32 + 8 * q) * 2); acc[0][mt] = mfma16(av, b0, acc[0][mt]); acc[1][mt] = mfma16(av, b1, acc[1][mt]); } }
    LAS float* sa = (LAS float*)(lds + 17408); LAS float* su = (LAS float*)(lds + 17408 + 33024);
    { const int ch = wave * 16 + c; const float ba = inp(I_LRUBA)[l * 768 + ch0 + ch], bi = inp(I_LRUBI)[l * 768 + ch0 + ch]; const float sp = log1pf(__expf(-inp(I_LAM)[l * 768 + ch0 + ch]));
#pragma unroll
        for (int mt = 0; mt < 4; ++mt)
#pragma unroll
            for (int r = 0; r < 4; ++r) { const int tok = mt * 16 + 4 * q + r; const float rg = sigm(acc[0][mt][r] + ba), ig = sigm(acc[1][mt][r] + bi);
                const float la = -8.f * rg * sp; const float av = __expf(la); const float mult = sqrtf(fmaxf(1.f - av * av, 0.f));
                const float xv = bflo((unsigned)*(const LAS bf16_t*)(lds + tok * 272 + ch * 2));
                sa[tok * 129 + ch] = av; su[tok * 129 + ch] = mult * ig * xv; } }
    __syncthreads();
    if (tid < 128) { const int ch = tid; float h = 0.f, pc = 1.f;
        bf16_t* HL = (bf16_t*)(ws + WS_HLOC) + (size_t)t0 * 768 + ch0 + ch; bf16_t* CP = (bf16_t*)(ws + WS_CUMP) + (size_t)t0 * 768 + ch0 + ch;
#pragma unroll 8
        for (int t = 0; t < 64; ++t) { const float av = sa[t * 129 + ch], uv = su[t * 129 + ch]; h = av * h + uv; pc *= av;
            HL[(size_t)t * 768] = (bf16_t)(cvt_pk_bf16(h, h) & 0xffffu); CP[(size_t)t * 768] = (bf16_t)(cvt_pk_bf16(pc, pc) & 0xffffu); }
        ((float*)(ws + WS_ATOT))[ci * 768 + ch0 + ch] = pc; ((float*)(ws + WS_HEND))[ci * 768 + ch0 + ch] = h; }
    __syncthreads();
}
__device__ __forceinline__ void lru_apply_item(unsigned char* ws, ldsp lds, int it, int tid) {
    asm volatile("" : "+v"(tid));
    const int g16 = it / 6, b = it % 6, ch0 = b * 128, c0 = g16 * 16;
    LAS float* sA = (LAS float*)lds; LAS float* sH = sA + 512; LAS float* sC = sH + 512;
    const float* at = (const float*)(ws + WS_ATOT) + ch0; const float* he = (const float*)(ws + WS_HEND) + ch0;
    { const int ch = tid & 127, part = tid >> 7; const int j0 = part * c0 / 4, j1 = (part + 1) * c0 / 4; float A = 1.f, H = 0.f;
#pragma unroll 16
        for (int j = j0; j < j1; ++j) { const float av = at[(size_t)j * 768 + ch], hv = he[(size_t)j * 768 + ch]; H = av * H + hv; A *= av; }
        sA[part * 128 + ch] = A; sH[part * 128 + ch] = H; }
    __syncthreads();
    if (tid < 128) { float cr = 0.f;
#pragma unroll
        for (int p = 0; p < 4; ++p) cr = sA[p * 128 + tid] * cr + sH[p * 128 + tid];
        sC[tid] = cr; }
    __syncthreads();
#pragma unroll 1
    for (int k = 0; k < 16; ++k) { const int ci = c0 + k, t0 = ci * 64;
        float na = 0.f, nh = 0.f; if (tid < 128) { na = at[(size_t)ci * 768 + tid]; nh = he[(size_t)ci * 768 + tid]; }
        { const int tok = tid >> 3, cg = (tid & 7) * 16; const size_t ro = (size_t)(t0 + tok) * 768 + ch0 + cg;
            const bf16_t* HL = (const bf16_t*)(ws + WS_HLOC) + ro; const bf16_t* CP = (const bf16_t*)(ws + WS_CUMP) + ro; const bf16_t* G = (const bf16_t*)(ws + WS_P) + (size_t)(t0 + tok) * PW + PC_AG + ch0 + cg;
            bf16_t* Y = (bf16_t*)(ws + WS_YA) + ro;
#pragma unroll
            for (int hf = 0; hf < 2; ++hf) { const u32x4 hv = *(const u32x4*)(HL + 8 * hf), cv = *(const u32x4*)(CP + 8 * hf), gv = *(const u32x4*)(G + 8 * hf); const LAS float* cc = sC + cg + 8 * hf;
                u32x4 w; w.x = cvt_pk_bf16((bflo(hv.x) + bflo(cv.x) * cc[0]) * bflo(gv.x), (bfhi(hv.x) + bfhi(cv.x) * cc[1]) * bfhi(gv.x));
                w.y = cvt_pk_bf16((bflo(hv.y) + bflo(cv.y) * cc[2]) * bflo(gv.y), (bfhi(hv.y) + bfhi(cv.y) * cc[3]) * bfhi(gv.y));
                w.z = cvt_pk_bf16((bflo(hv.z) + bflo(cv.z) * cc[4]) * bflo(gv.z), (bfhi(hv.z) + bfhi(cv.z) * cc[5]) * bfhi(gv.z));
                w.w = cvt_pk_bf16((bflo(hv.w) + bflo(cv.w) * cc[6]) * bflo(gv.w), (bfhi(hv.w) + bfhi(cv.w) * cc[7]) * bfhi(gv.w));
                *(u32x4*)(Y + 8 * hf) = w; } }
        __syncthreads();
        if (tid < 128) sC[tid] = na * sC[tid] + nh;
        __syncthreads(); }
}
__device__ __forceinline__ void vt_item(unsigned char* ws, ldsp lds, int tt, int tid) {
    asm volatile("" : "+v"(tid));
    const int lane = tid & 63, wave = __builtin_amdgcn_readfirstlane(tid >> 6);
    const bf16_t* P = (const bf16_t*)(ws + WS_P);
#pragma unroll 1
    for (int grp = 0; grp < 3; ++grp) {
        { const int tok = tid >> 3, ch = tid & 7;
#pragma unroll
            for (int s6 = 0; s6 < 6; ++s6) { const int s = grp * 6 + s6; const int sc = s < 3 ? PC_VS + s * 64 : s < 6 ? PC_VW + (s - 3) * 64 : PC_CV + (s - 6) * 64;
                const u32x4 v = *(const u32x4*)(P + (size_t)(tt * 64 + tok) * PW + sc + ch * 8); *(LAS u32x4*)(lds + tok * 784 + (s6 * 64 + ch * 8) * 2) = v; } }
        __syncthreads();
#pragma unroll
        for (int s6 = 0; s6 < 6; ++s6) { const int s = grp * 6 + s6; unsigned short e[8];
            const int dsel = s < 10 ? 0 : s < 14 ? 1 : 2;
#pragma unroll
            for (int i = 0; i < 8; ++i) { const int tok = dsel == 0 ? wave * 8 + i : dsel == 1 ? (wave & 3) + 4 * (8 * (wave >> 2) + i) : 2 * wave + (i >> 2) + 16 * (i & 3);
                e[i] = *(const LAS unsigned short*)(lds + tok * 784 + (s6 * 64 + lane) * 2); }
            u32x4 w; w.x = e[0] | ((unsigned)e[1] << 16); w.y = e[2] | ((unsigned)e[3] << 16); w.z = e[4] | ((unsigned)e[5] << 16); w.w = e[6] | ((unsigned)e[7] << 16);
            const size_t dofs = s < 3 ? WS_VTS + (size_t)(s * 64 + lane) * S * 2 : s < 6 ? WS_VTW + (size_t)((s - 3) * 64 + lane) * S * 2 : WS_VTC + (size_t)((s - 6) * 64 + lane) * S * 2; bf16_t* dst = (bf16_t*)(ws + dofs);
            if (dsel == 0) *(u32x4*)(dst + tt * 64 + wave * 8) = w;
            else if (dsel == 1) *(u32x4*)(dst + (wave & 3) * (S / 4) + tt * 16 + 8 * (wave >> 2)) = w;
            else { u32x2 w0, w1; w0.x = w.x; w0.y = w.y; w1.x = w.z; w1.y = w.w; *(u32x2*)(dst + (2 * wave) * (S / 16) + tt * 4) = w0; *(u32x2*)(dst + (2 * wave + 1) * (S / 16) + tt * 4) = w1; } }
        __syncthreads();
    }
}

#define ssql ((float*)(wsl + WS_SSQ))
#define Xl ((float*)inp(29))
#define XBl ((bf16_t*)(wsl + WS_XB))
#define ctrl ((unsigned*)(wsl + WS_CTR))
#define wt (wsl + WS_WT)
#define P ((bf16_t*)(wsl + WS_P))
#define HID ((bf16_t*)(wsl + WS_HID))
#define MG ((bf16_t*)(wsl + WS_MERGED))
#define XBAR() do { XcdBarrier xb_; xb_.bar = (unsigned*)(wsl + WS_BAR); xb_.x = xb_xcc_id(); xb_.st = (volatile LAS unsigned*)(lds + LDS_BYTES - 32); xcd_barrier(xb_); } while (0)
#ifndef PH
#define PH 0xFFFF
#endif
__device__ __forceinline__ int next_item(unsigned* ctr, LAS int* slot, int tid) {
    __syncthreads(); if (tid == 0) *slot = (int)atomicAdd(ctr, 1u); __syncthreads(); return *slot;
}
template <class Epi>
__device__ __forceinline__ void run_gemm(ldsp lds, const bf16_t* A, const bf16_t* Bt, int N, int K, const Epi& E) {
    pg8::Gemm g{A, Bt, S, N, K}; pg8::StaticOrder So; So.init(S, N, (int)gridDim.x, (int)blockIdx.x);
    pg8::gemm_phase<Epi, pg8::StaticOrder, true, true>(lds, g, So, E);
}

__global__ void __launch_bounds__(NT, 2) mega(Args a) {
    extern __shared__ __attribute__((aligned(16))) unsigned char lds_raw[];
    ldsp lds = (ldsp)lds_raw;
    LAS int* slot = (LAS int*)(lds + LDS_BYTES - 64);
    cg::grid_group grid = cg::this_grid();
    const int tid = threadIdx.x, lane = tid & 63, wave = tid >> 6;
    const int gw = blockIdx.x * 8 + wave, NGW = gridDim.x * 8;
    unsigned char* ws = (unsigned char*)inp(30);
    float* ssq = (float*)(ws + WS_SSQ); unsigned* ctr = (unsigned*)(ws + WS_CTR);
    float* X = (float*)inp(29); bf16_t* XB = (bf16_t*)(ws + WS_XB);
    for (int m = gw; m < S; m += NGW) {
        const float4* xr = (const float4*)(inp(I_X) + (size_t)m * DM) + lane; float4* orow = (float4*)(X + (size_t)m * DM) + lane; u32x2* xb = (u32x2*)(XB + (size_t)m * DM) + lane;
        float s = 0.f;
#pragma unroll
        for (int j = 0; j < 4; ++j) { const float4 v = xr[64 * j]; s += v.x * v.x + v.y * v.y + v.z * v.z + v.w * v.w; orow[64 * j] = v; u32x2 w; w.x = cvt_pk_bf16(v.x, v.y); w.y = cvt_pk_bf16(v.z, v.w); xb[64 * j] = w; }
        s = wave_sum(s);
        if (lane < 16) ssq[(size_t)m * 16 + lane] = lane == 0 ? s : 0.f;
    }
    if (blockIdx.x == 0 && tid < 64) ctr[tid] = 0u;
    if (blockIdx.x == 0) for (int i = tid; i < XCD_BAR_WORDS; i += NT) ((unsigned*)(ws + WS_BAR))[i] = 0u;
    volatile LAS unsigned* bst = (volatile LAS unsigned*)(lds + LDS_BYTES - 32); if (tid < 2) bst[tid] = 0u;
    prep_phase(ws, 0, 0, lds, tid); prep_phase(ws, 0, 1, lds, tid);
    grid.sync();
    (void)xcd_barrier_post((unsigned*)(ws + WS_BAR), bst);
#pragma unroll 1
    for (int l = 0; l < NL; ++l) {
        int tl = threadIdx.x; asm volatile("" : "+v"(tl));
        unsigned long long wsb = (unsigned long long)ws; asm volatile("" : "+s"(wsb)); unsigned char* wsl = (unsigned char*)(__attribute__((address_space(1))) unsigned char*)wsb;
#if PH & 1
        run_gemm(lds, XBl, (const bf16_t*)(wt + WT_W13A), 5632, 1024, pg8::EpiSwiGLU{HID, ssql});
#endif
#if defined(DUP_X) && (DUP_X & 4)
        XBAR(); run_gemm(lds, XBl, (const bf16_t*)(wt + WT_W13A), 5632, 1024, pg8::EpiSwiGLU{HID, ssql});
#endif
        XBAR(); asm volatile("" : "+s"(wsb)); wsl = (unsigned char*)(__attribute__((address_space(1))) unsigned char*)wsb;
#if PH & 2
        run_gemm(lds, HID, (const bf16_t*)(wt + WT_W2A), 1024, 2816, pg8::EpiResid{Xl, XBl, ssql, 0.5f});
#endif
        XBAR(); asm volatile("" : "+s"(wsb)); wsl = (unsigned char*)(__attribute__((address_space(1))) unsigned char*)wsb;
#if PH & 4
        run_gemm(lds, XBl, (const bf16_t*)(wt + WT_WIN), PW, 1024, pg8::EpiProj{P, ssql});
#endif
#if defined(DUP_X) && (DUP_X & 8)
        XBAR(); run_gemm(lds, XBl, (const bf16_t*)(wt + WT_WIN), PW, 1024, pg8::EpiProj{P, ssql});
#endif
        XBAR(); asm volatile("" : "+s"(wsb)); wsl = (unsigned char*)(__attribute__((address_space(1))) unsigned char*)wsb;
#if PH & 8
        for (;;) { const int it = next_item(ctrl + 2 * l, slot, tl); if (it >= 1984 + PREP_GC_B) break;
            if (it < 192) cmp_item(wsl, lds, it, tl); else if (it < 448) vt_item(wsl, lds, it - 192, tl); else if (it < 1984) lru_tile_item(wsl, lds, it - 448, l, tl); else prep_block_item(wsl, l, 2, it - 1984, lds, tl); }
#endif
#if defined(DUP_X) && (DUP_X & 2)
        XBAR();
        for (;;) { const int it = next_item(ctrl + 24 + l, slot, tl); if (it >= 192 + 256 + 1536) break;
            if (it < 192) cmp_item(wsl, lds, it, tl); else if (it < 448) vt_item(wsl, lds, it - 192, tl); else lru_tile_item(wsl, lds, it - 448, l, tl); }
#endif
        XBAR(); asm volatile("" : "+s"(wsb)); wsl = (unsigned char*)(__attribute__((address_space(1))) unsigned char*)wsb;
#if PH & 16
        { const int nprep = (l + 1 < NL) ? PREP_GA_B + PREP_GB_B : 0;
        for (;;) { const int it = next_item(ctrl + 2 * l + 1, slot, tl); if (it >= 2400 + nprep) break;
            if (it < 96) lru_apply_item(wsl, lds, it, tl); else if (it < 864) { const int ni = it - 96; nsa_item<31>(wsl, lds, 255 - (ni & 255), ni >> 8, tl); } else if (it < 2400) dil_task(wsl, (it - 864) * 8 + (tl >> 6), tl & 63);
            else if (it < 2400 + PREP_GA_B) prep_block_item(wsl, l + 1, 0, it - 2400, lds, tl); else prep_block_item(wsl, l + 1, 1, it - 2400 - PREP_GA_B, lds, tl); } }
#endif
#ifdef DUP_NSA
        XBAR(); asm volatile("" : "+s"(wsb)); wsl = (unsigned char*)(__attribute__((address_space(1))) unsigned char*)wsb;
        for (;;) { const int it = next_item(ctrl + 16 + l, slot, tl); if (it >= 768) break; nsa_item<DUP_NSA>(wsl, lds, 255 - (it & 255), it >> 8, tl); }
#endif
#ifdef DUP_M2ALL
        XBAR(); asm volatile("" : "+s"(wsb)); wsl = (unsigned char*)(__attribute__((address_space(1))) unsigned char*)wsb;
        { const int nprep = (l + 1 < NL) ? PREP_GA_B + PREP_GB_B : 0;
        for (;;) { const int it = next_item(ctrl + 16 + l, slot, tl); if (it >= 2400 + nprep) break;
            if (it < 96) lru_apply_item(wsl, lds, it, tl); else if (it < 864) { const int ni = it - 96; nsa_item<31>(wsl, lds, 255 - (ni & 255), ni >> 8, tl); } else if (it < 2400) dil_task(wsl, (it - 864) * 8 + (tl >> 6), tl & 63);
            else if (it < 2400 + PREP_GA_B) prep_block_item(wsl, l + 1, 0, it - 2400, lds, tl); else prep_block_item(wsl, l + 1, 1, it - 2400 - PREP_GA_B, lds, tl); } }
#endif
        XBAR(); asm volatile("" : "+s"(wsb)); wsl = (unsigned char*)(__attribute__((address_space(1))) unsigned char*)wsb;
        dil_combine(wsl, tl);
        XBAR(); asm volatile("" : "+s"(wsb)); wsl = (unsigned char*)(__attribute__((address_space(1))) unsigned char*)wsb;
#if PH & 32
        run_gemm(lds, (const bf16_t*)(wsl + WS_YA), (const bf16_t*)(wt + WT_UA), 1024, 768, pg8::EpiMerge<0>{MG, P + PC_MA});
        run_gemm(lds, (const bf16_t*)(wsl + WS_NSAO), (const bf16_t*)(wt + WT_UB), 1024, 768, pg8::EpiMerge<1>{MG, P + PC_MB});
        run_gemm(lds, (const bf16_t*)(wsl + WS_DILO), (const bf16_t*)(wt + WT_UC), 1024, 256, pg8::EpiMerge<1>{MG, P + PC_MC});
#endif
        XBAR(); asm volatile("" : "+s"(wsb)); wsl = (unsigned char*)(__attribute__((address_space(1))) unsigned char*)wsb;
#if PH & 64
        run_gemm(lds, MG, (const bf16_t*)(wt + WT_WO), 1024, 1024, pg8::EpiResid{Xl, XBl, ssql, 1.0f});
#endif
        XBAR(); asm volatile("" : "+s"(wsb)); wsl = (unsigned char*)(__attribute__((address_space(1))) unsigned char*)wsb;
#if defined(DUP_X) && (DUP_X & 16)
        for (int k = 0; k < 8; ++k) XBAR();
#endif
#if PH & 128
        run_gemm(lds, XBl, (const bf16_t*)(wt + WT_W13B), 5632, 1024, pg8::EpiSwiGLU{HID, ssql});
#endif
        XBAR(); asm volatile("" : "+s"(wsb)); wsl = (unsigned char*)(__attribute__((address_space(1))) unsigned char*)wsb;
#if PH & 256
        run_gemm(lds, HID, (const bf16_t*)(wt + WT_W2B), 1024, 2816, pg8::EpiResid{Xl, XBl, ssql, 0.5f});
#endif
        XBAR(); asm volatile("" : "+s"(wsb)); wsl = (unsigned char*)(__attribute__((address_space(1))) unsigned char*)wsb;
    }
    int tf = threadIdx.x; asm volatile("" : "+v"(tf));
    unsigned char* wsf = (unsigned char*)inp(30); float* Xf = (float*)inp(29);
    const int lanef = tf & 63; const int gwf = blockIdx.x * 8 + (tf >> 6);
    for (int m = gwf; m < S; m += NGW) {
        float4* orow = (float4*)(Xf + (size_t)m * DM) + lanef; const float4* g = (const float4*)(inp(I_FINN)) + lanef;
        const float r = rsqrtf(pg8::rsum16((const float*)(wsf + WS_SSQ), m) * (1.f / DM) + 1e-6f);
#pragma unroll
        for (int j = 0; j < 4; ++j) { float4 v = orow[64 * j]; const float4 gg = g[64 * j]; v.x *= r * gg.x; v.y *= r * gg.y; v.z *= r * gg.z; v.w *= r * gg.w; orow[64 * j] = v; }
    }
}

#undef ssql
#undef Xl
#undef XBl
#undef ctrl
#undef wt
#undef P
#undef HID
#undef MG
extern "C" void kernel_launch(void* const* d_in, const int* in_sizes, int n_in, void* d_out, int out_size, void* d_ws, size_t ws_size, hipStream_t stream) {
    static int grid_blocks = 0;
    if (!grid_blocks) {
        int dev = 0, cus = 0, per_cu = 0;
        (void)hipGetDevice(&dev);
        (void)hipDeviceGetAttribute(&cus, hipDeviceAttributeMultiprocessorCount, dev);
        (void)hipFuncSetAttribute((const void*)mega, hipFuncAttributeMaxDynamicSharedMemorySize, LDS_BYTES);
        (void)hipOccupancyMaxActiveBlocksPerMultiprocessor(&per_cu, (const void*)mega, NT, LDS_BYTES);
        if (per_cu < 1) per_cu = 1;
        grid_blocks = cus * per_cu;
        if (ws_size < WS_END) { fprintf(stderr, "kernel_launch: workspace too small: %zu < %zu\n", ws_size, (size_t)WS_END); grid_blocks = -1; }
    }
    if (grid_blocks < 0) return;
    Args a{};
    for (int i = 0; i < 29; ++i) a.in[i] = (const float*)d_in[i];
    a.out = (float*)d_out; a.ws = (unsigned char*)d_ws;
    void* args[] = {&a};
    hipError_t e = hipLaunchCooperativeKernel((const void*)mega, dim3(grid_blocks), dim3(NT), args, LDS_BYTES, stream);
    if (e != hipSuccess) fprintf(stderr, "cooperative launch failed: %s (grid %d)\n", hipGetErrorString(e), grid_blocks);
}
```

```cpp
#include <hip/hip_runtime.h>
#include <hip/hip_cooperative_groups.h>
#include <cstdio>
#include <cstdint>
namespace cg = cooperative_groups;
namespace pg8 {
#define PG8_LAS __attribute__((address_space(3)))
typedef unsigned short bf16_t;
typedef short bf16x8 __attribute__((ext_vector_type(8)));
typedef float f32x4 __attribute__((ext_vector_type(4)));
typedef unsigned u32x4 __attribute__((ext_vector_type(4)));
constexpr int BM = 256, BK = 64, HALF = 128, HTB = HALF * BK * 2  , STAGE_BYTES = 8 * HTB, NXCD = 8, WGM = 8;

__host__ __device__ __forceinline__ int lds_byte(int r, int c) { const int st = (r >> 4) * 2 + (c >> 5), rr = r & 15, cc = c & 31, ob = rr * 64 + cc * 2; return st * 1024 + (ob ^ (((ob >> 9) & 1) << 5)); }
__host__ __device__ __forceinline__ void stage_rc(int b, int& R, int& C) { const int st = b / 1024, sb = b % 1024, swz = sb ^ (((sb >> 9) & 1) << 5); R = (st >> 1) * 16 + swz / 64; C = (st & 1) * 32 + (swz % 64) / 2; }
__host__ __device__ __forceinline__ int perm32(int rho) { const int n = rho >> 4, i = rho & 15; return 8 * (i >> 2) + 4 * n + (i & 3); }

struct Unit { int pm, pn; };
struct Gemm { const bf16_t* A; const bf16_t* Bt; int M, N, K; };

struct StaticOrder {
    int nM, nN, nwg, G, c;
    __host__ __device__ void init(int M, int N, int G_, int c_) { nM = M / BM; nN = N / BM; nwg = nM * nN; G = G_; c = c_; }
    __host__ __device__ bool next(int i, Unit& u) const {
        const long L = (long)i * G + c; if (L >= nwg) return false;
        int wgid = (int)L; { const int q = nwg / NXCD, r = nwg % NXCD, xcd = wgid % NXCD, off = wgid / NXCD; wgid = (xcd < r ? xcd * (q + 1) : r * (q + 1) + (xcd - r) * q) + off; }
        const int nig = WGM * nN, gid = wgid / nig, fm = gid * WGM, gsz = (nM - fm) < WGM ? (nM - fm) : WGM;
        u.pm = fm + ((wgid % nig) % gsz); u.pn = (wgid % nig) / gsz; return true;
    }
    __device__ __forceinline__ void a_ready(const Unit&) const {}
    __device__ __forceinline__ void done(const Unit&) const {}
};

typedef unsigned u32x2 __attribute__((ext_vector_type(2)));
typedef float f32x2_t __attribute__((ext_vector_type(2))); typedef __bf16 bf16x2_t __attribute__((ext_vector_type(2)));
__device__ __forceinline__ unsigned cvt_pk_bf16(float lo, float hi) { const f32x2_t v = {lo, hi}; const bf16x2_t b = __builtin_convertvector(v, bf16x2_t); return __builtin_bit_cast(unsigned, b); }
__device__ __forceinline__ float bflo(unsigned u) { return __uint_as_float(u << 16); }
__device__ __forceinline__ float bfhi(unsigned u) { return __uint_as_float(u & 0xffff0000u); }
__device__ __forceinline__ float sigm(float v) { return __builtin_amdgcn_rcpf(1.f + __expf(-v)); }
__device__ __forceinline__ float gelu_t(float v) { const float u = 1.5957691216f * (v + 0.044715f * v * v * v); return v * sigm(u); }

constexpr int DM = 1024, DFF = 2816, PW = 8960;
constexpr float RMS_EPS = 1e-6f;
__device__ __forceinline__ float rsum16(const float* ssq, int row) { const f32x4* p = (const f32x4*)(ssq + (size_t)row * 16); const f32x4 a = p[0], b = p[1], c = p[2], d = p[3];
    return (((a[0] + a[1]) + (a[2] + a[3])) + ((b[0] + b[1]) + (b[2] + b[3]))) + (((c[0] + c[1]) + (c[2] + c[3])) + ((d[0] + d[1]) + (d[2] + d[3]))); }
constexpr int PC_AX = 0, PC_AG = 768, PC_BQ = 1536, PC_CQ = 2304, PC_CK = 3072, PC_CV = 3840, PC_MA = 4608, PC_MB = 5632, PC_MC = 6656,
              PC_KC = 7680, PC_VC = 7872, PC_KS = 8064, PC_VS = 8256, PC_KW = 8448, PC_VW = 8640, PC_BG = 8832;
constexpr float QSCALE = 0.125f * 1.4426950408889634f;

struct EpiSwiGLU {
    static constexpr bool PERM = true, AFTER_DRAIN = false;
    bf16_t* H; const float* ssq;
    __device__ __forceinline__ void operator()(const f32x4 (&acc)[2][2][4][2], const Unit& u, int wr, int wc, int fr, int fq) const {
        const int row0 = u.pm * BM + wr * 64 + fr; const int hc0 = u.pn * 128 + wc * 16 + 4 * fq;
#pragma unroll
        for (int ai = 0; ai < 2; ++ai)
#pragma unroll
            for (int m = 0; m < 4; ++m) { const int row = row0 + ai * HALF + m * 16; const float rs = rsqrtf(rsum16(ssq, row) * (1.f / DM) + RMS_EPS);
#pragma unroll
                for (int bj = 0; bj < 2; ++bj) { const f32x4 a = acc[ai][bj][m][0] * rs, b = acc[ai][bj][m][1] * rs; float h[4];
#pragma unroll
                    for (int i = 0; i < 4; ++i) h[i] = a[i] * sigm(a[i]) * b[i];
                    u32x2 w; w.x = cvt_pk_bf16(h[0], h[1]); w.y = cvt_pk_bf16(h[2], h[3]);
                    *(u32x2*)(H + (size_t)row * DFF + hc0 + bj * 64) = w; } }
    }
};
struct EpiResid {
    static constexpr bool PERM = false, AFTER_DRAIN = false;
    float* X; bf16_t* XB; float* ssq_out; float scale;
    __device__ __forceinline__ void operator()(const f32x4 (&acc)[2][2][4][2], const Unit& u, int wr, int wc, int fr, int fq) const {
        const int row0 = u.pm * BM + wr * 64 + fr; const int col0 = u.pn * BM + wc * 32 + 4 * fq;
#pragma unroll
        for (int ai = 0; ai < 2; ++ai)
#pragma unroll
            for (int m = 0; m < 4; ++m) { const int row = row0 + ai * HALF + m * 16; float ss = 0.f;
#pragma unroll
                for (int bj = 0; bj < 2; ++bj)
#pragma unroll
                    for (int n = 0; n < 2; ++n) { const size_t off = (size_t)row * DM + col0 + bj * HALF + n * 16;
                        f32x4 xv = *(const f32x4*)(X + off); xv = xv + acc[ai][bj][m][n] * scale; *(f32x4*)(X + off) = xv;
                        u32x2 w; w.x = cvt_pk_bf16(xv[0], xv[1]); w.y = cvt_pk_bf16(xv[2], xv[3]); *(u32x2*)(XB + off) = w;
                        ss += (xv[0] * xv[0] + xv[1] * xv[1]) + (xv[2] * xv[2] + xv[3] * xv[3]); }
                ss += __shfl_xor(ss, 16); ss += __shfl_xor(ss, 32);
                if (fq == 0) ssq_out[(size_t)row * 16 + u.pn * 4 + wc] = ss; }
    }
};
struct EpiProj {
    static constexpr bool PERM = true, AFTER_DRAIN = false;
    bf16_t* P; const float* ssq;
    __device__ __forceinline__ void operator()(const f32x4 (&acc)[2][2][4][2], const Unit& u, int wr, int wc, int fr, int fq) const {
        const int row0 = u.pm * BM + wr * 64 + fr; const int col0 = u.pn * BM + wc * 32 + 8 * fq;
        const int pn = u.pn; const int act = (pn >= 3 && pn < 6) ? 1 : (pn >= 6 && pn < 12) ? 2 : (pn >= 18 && pn < 30) ? 3 : 0;
#pragma unroll
        for (int ai = 0; ai < 2; ++ai)
#pragma unroll
            for (int m = 0; m < 4; ++m) { const int row = row0 + ai * HALF + m * 16; float rs = rsqrtf(rsum16(ssq, row) * (1.f / DM) + RMS_EPS); if (act == 2) rs *= QSCALE;
#pragma unroll
                for (int bj = 0; bj < 2; ++bj) { f32x4 v0 = acc[ai][bj][m][0] * rs, v1 = acc[ai][bj][m][1] * rs;
                    if (act == 1) {
#pragma unroll
                        for (int i = 0; i < 4; ++i) { v0[i] = gelu_t(v0[i]); v1[i] = gelu_t(v1[i]); } }
                    else if (act == 3) {
#pragma unroll
                        for (int i = 0; i < 4; ++i) { v0[i] = sigm(v0[i]); v1[i] = sigm(v1[i]); } }
                    u32x4 w; w.x = cvt_pk_bf16(v0[0], v0[1]); w.y = cvt_pk_bf16(v0[2], v0[3]); w.z = cvt_pk_bf16(v1[0], v1[1]); w.w = cvt_pk_bf16(v1[2], v1[3]);
                    *(u32x4*)(P + (size_t)row * PW + col0 + bj * HALF) = w; } }
    }
};
template <int ACCUM> struct EpiMerge {
    static constexpr bool PERM = true, AFTER_DRAIN = false;
    bf16_t* Mg; const bf16_t* G;
    __device__ __forceinline__ void operator()(const f32x4 (&acc)[2][2][4][2], const Unit& u, int wr, int wc, int fr, int fq) const {
        const int row0 = u.pm * BM + wr * 64 + fr; const int col0 = u.pn * BM + wc * 32 + 8 * fq;
#pragma unroll
        for (int ai = 0; ai < 2; ++ai)
#pragma unroll
            for (int m = 0; m < 4; ++m) { const int row = row0 + ai * HALF + m * 16;
#pragma unroll
                for (int bj = 0; bj < 2; ++bj) { const u32x4 g = *(const u32x4*)(G + (size_t)row * PW + col0 + bj * HALF);
                    const f32x4 a0 = acc[ai][bj][m][0], a1 = acc[ai][bj][m][1];
                    float v[8] = {bflo(g.x) * a0[0], bfhi(g.x) * a0[1], bflo(g.y) * a0[2], bfhi(g.y) * a0[3], bflo(g.z) * a1[0], bfhi(g.z) * a1[1], bflo(g.w) * a1[2], bfhi(g.w) * a1[3]};
                    bf16_t* mp = Mg + (size_t)row * DM + col0 + bj * HALF;
                    if (ACCUM) { const u32x4 o = *(const u32x4*)mp; v[0] += bflo(o.x); v[1] += bfhi(o.x); v[2] += bflo(o.y); v[3] += bfhi(o.y); v[4] += bflo(o.z); v[5] += bfhi(o.z); v[6] += bflo(o.w); v[7] += bfhi(o.w); }
                    u32x4 w; w.x = cvt_pk_bf16(v[0], v[1]); w.y = cvt_pk_bf16(v[2], v[3]); w.z = cvt_pk_bf16(v[4], v[5]); w.w = cvt_pk_bf16(v[6], v[7]);
                    *(u32x4*)mp = w; } }
    }
};

template <class Epi, class Sched, bool ALIGN_EPI = false, bool SP2 = false>
__device__ __forceinline__ void gemm_phase(PG8_LAS unsigned char* lds, const Gemm g, const Sched& S, const Epi& E) {
    int tid = threadIdx.x; asm volatile("" : "+v"(tid));
    const int wid = __builtin_amdgcn_readfirstlane(tid >> 6), lane = tid & 63, wr = wid >> 2, wc = wid & 3, fr = lane & 15, fq = lane >> 4;
    const int K = g.K, nt = K / BK;
    unsigned voffA[2], voffB[2];
#pragma unroll
    for (int i = 0; i < 2; ++i) { int R, C; stage_rc(tid * 16 + i * 8192, R, C); const int Rb = Epi::PERM ? ((R & ~31) + perm32(R & 31)) : R;
        voffA[i] = (unsigned)(R * K + C) * 2u; voffB[i] = (unsigned)(Rb * K + C) * 2u; }
    const size_t kstep = (size_t)(BK * 2);
    const size_t hstep = (size_t)HALF * K * 2;
    const size_t tstep = 2 * hstep;
    const unsigned ldsw = (unsigned)wid * 1024u;
    const int aoff = lds_byte(wr * 64 + fr, fq * 8), boff = lds_byte(wc * 32 + fr, fq * 8);
#define PG8_SA(b, h) (((b) * 2 + (h)) * HTB)
#define PG8_SB(b, h) ((4 + (b) * 2 + (h)) * HTB)
#define PG8_STAGE(bufoff, gbase, voff) do { _Pragma("unroll") for (int _i = 0; _i < 2; ++_i) \
        __builtin_amdgcn_global_load_lds((const unsigned*)((const char*)(gbase) + (voff)[_i]), (PG8_LAS unsigned*)(lds + (bufoff) + ldsw + _i * 8192), 16, 0, 0); } while (0)
#define PG8_LDA(dst, b, h) do { _Pragma("unroll") for (int m = 0; m < 4; ++m) _Pragma("unroll") for (int k = 0; k < 2; ++k) dst[m][k] = *(const PG8_LAS bf16x8*)(lds + PG8_SA(b, h) + aoff + m * 2048 + k * 1024); } while (0)
#define PG8_LDB(dst, b, h) do { _Pragma("unroll") for (int n = 0; n < 2; ++n) _Pragma("unroll") for (int k = 0; k < 2; ++k) dst[n][k] = *(const PG8_LAS bf16x8*)(lds + PG8_SB(b, h) + boff + n * 2048 + k * 1024); } while (0)
#define PG8_MMA(ai, bj, At, Bt) do { __builtin_amdgcn_s_setprio(1); _Pragma("unroll") for (int m = 0; m < 4; ++m) _Pragma("unroll") for (int n = 0; n < 2; ++n) _Pragma("unroll") for (int k = 0; k < 2; ++k) \
        acc[ai][bj][m][n] = __builtin_amdgcn_mfma_f32_16x16x32_bf16(Bt[n][k], At[m][k], acc[ai][bj][m][n], 0, 0, 0); __builtin_amdgcn_s_setprio(0); } while (0)
#define PG8_WAIT_V(n) asm volatile("s_waitcnt vmcnt(" #n ")" ::: "memory")
#define PG8_WAIT_L(n) asm volatile("s_waitcnt lgkmcnt(" #n ")" ::: "memory")
#define PG8_BAR __builtin_amdgcn_s_barrier()
#define PG8_SCHED __builtin_amdgcn_sched_barrier(0)
    Unit cur, nxt; int ui = 0;
    if (!S.next(0, cur)) return;
    f32x4 acc[2][2][4][2];
#pragma unroll
    for (int a = 0; a < 2; ++a)
#pragma unroll
        for (int b = 0; b < 2; ++b)
#pragma unroll
            for (int m = 0; m < 4; ++m)
#pragma unroll
                for (int n = 0; n < 2; ++n) acc[a][b][m][n] = (f32x4){0.f, 0.f, 0.f, 0.f};
    bf16x8 At[4][2], B0[2][2], B1[2][2];
    const char* cA = (const char*)g.A + (size_t)cur.pm * tstep; const char* cB = (const char*)g.Bt + (size_t)cur.pn * tstep;
    S.a_ready(cur);
    if constexpr (SP2) {
        PG8_STAGE(PG8_SB(0, 0), cB, voffB); PG8_STAGE(PG8_SB(0, 1), cB + hstep, voffB); PG8_STAGE(PG8_SA(0, 0), cA, voffA); PG8_STAGE(PG8_SA(0, 1), cA + hstep, voffA);
        if (wr == 1) PG8_BAR;
        PG8_WAIT_V(2); PG8_BAR;
        PG8_STAGE(PG8_SB(1, 0), cB + kstep, voffB); PG8_STAGE(PG8_SA(1, 0), cA + kstep, voffA); PG8_STAGE(PG8_SB(1, 1), cB + hstep + kstep, voffB);
        PG8_WAIT_V(6); PG8_BAR;
    } else {
        PG8_STAGE(PG8_SB(0, 0), cB, voffB); PG8_STAGE(PG8_SA(0, 0), cA, voffA); PG8_STAGE(PG8_SB(0, 1), cB + hstep, voffB); PG8_STAGE(PG8_SA(0, 1), cA + hstep, voffA);
        if (wr == 1) PG8_BAR;
        PG8_WAIT_V(4); PG8_BAR;
        PG8_STAGE(PG8_SB(1, 0), cB + kstep, voffB); PG8_STAGE(PG8_SA(1, 0), cA + kstep, voffA); PG8_STAGE(PG8_SB(1, 1), cB + hstep + kstep, voffB);
        PG8_WAIT_V(6); PG8_BAR;
    }
    for (;;) {
        const bool has_next = S.next(ui + 1, nxt);
        const char* nA = has_next ? (const char*)g.A + (size_t)nxt.pm * tstep : cA; const char* nB = has_next ? (const char*)g.Bt + (size_t)nxt.pn * tstep : cB;
        for (int t = 0; t < nt; t += 2) {
            const bool last = (t == nt - 2);
            const char* a1 = cA + (size_t)(t + 1) * kstep;
            const char* a2 = last ? nA : cA + (size_t)(t + 2) * kstep; const char* b2 = last ? nB : cB + (size_t)(t + 2) * kstep;
            const char* a3 = a2 + kstep; const char* b3 = b2 + kstep;
            if (last && has_next) S.a_ready(nxt);
            if constexpr (SP2) {
            PG8_LDB(B0, 0, 0); PG8_LDB(B1, 0, 1); PG8_SCHED; PG8_LDA(At, 0, 0); PG8_STAGE(PG8_SA(1, 1), a1 + hstep, voffA);
            PG8_WAIT_V(8); PG8_WAIT_L(0); PG8_BAR; PG8_MMA(0, 0, At, B0); PG8_MMA(0, 1, At, B1); PG8_BAR; PG8_SCHED;
            PG8_LDA(At, 0, 1); PG8_STAGE(PG8_SB(0, 0), b2, voffB); PG8_STAGE(PG8_SB(0, 1), b2 + hstep, voffB); PG8_STAGE(PG8_SA(0, 0), a2, voffA);
            PG8_WAIT_V(8); PG8_WAIT_L(0); PG8_BAR; PG8_MMA(1, 0, At, B0); PG8_MMA(1, 1, At, B1); PG8_BAR; PG8_SCHED;
            PG8_LDB(B0, 1, 0); PG8_LDB(B1, 1, 1); PG8_SCHED; PG8_LDA(At, 1, 0); PG8_STAGE(PG8_SA(0, 1), a2 + hstep, voffA);
            PG8_WAIT_V(8); PG8_WAIT_L(0); PG8_BAR; PG8_MMA(0, 0, At, B0); PG8_MMA(0, 1, At, B1); PG8_BAR; PG8_SCHED;
            PG8_LDA(At, 1, 1); PG8_STAGE(PG8_SB(1, 0), b3, voffB); PG8_STAGE(PG8_SB(1, 1), b3 + hstep, voffB); PG8_STAGE(PG8_SA(1, 0), a3, voffA);
            PG8_WAIT_V(8); PG8_WAIT_L(0); PG8_BAR; PG8_MMA(1, 0, At, B0); PG8_MMA(1, 1, At, B1); PG8_BAR; PG8_SCHED;
            } else {
            PG8_LDB(B0, 0, 0); PG8_SCHED; PG8_LDA(At, 0, 0); PG8_STAGE(PG8_SA(1, 1), a1 + hstep, voffA);
            PG8_WAIT_L(8); PG8_BAR; PG8_WAIT_L(0); PG8_MMA(0, 0, At, B0); PG8_BAR; PG8_SCHED;
            PG8_LDB(B1, 0, 1); PG8_STAGE(PG8_SB(0, 0), b2, voffB);
            PG8_BAR; PG8_WAIT_L(0); PG8_MMA(0, 1, At, B1); PG8_BAR;
            PG8_LDA(At, 0, 1); PG8_STAGE(PG8_SA(0, 0), a2, voffA);
            PG8_BAR; PG8_WAIT_L(0); PG8_MMA(1, 0, At, B0); PG8_BAR; PG8_SCHED;
            PG8_STAGE(PG8_SB(0, 1), b2 + hstep, voffB);
            PG8_WAIT_V(6); PG8_BAR; PG8_MMA(1, 1, At, B1); PG8_BAR;
            PG8_LDB(B0, 1, 0); PG8_SCHED; PG8_LDA(At, 1, 0); PG8_STAGE(PG8_SA(0, 1), a2 + hstep, voffA);
            PG8_WAIT_L(8); PG8_BAR; PG8_WAIT_L(0); PG8_MMA(0, 0, At, B0); PG8_BAR; PG8_SCHED;
            PG8_LDB(B1, 1, 1); PG8_STAGE(PG8_SB(1, 0), b3, voffB);
            PG8_BAR; PG8_WAIT_L(0); PG8_MMA(0, 1, At, B1); PG8_BAR;
            PG8_LDA(At, 1, 1); PG8_STAGE(PG8_SA(1, 0), a3, voffA);
            PG8_BAR; PG8_WAIT_L(0); PG8_MMA(1, 0, At, B0); PG8_BAR; PG8_SCHED;
            PG8_STAGE(PG8_SB(1, 1), b3 + hstep, voffB);
            PG8_WAIT_V(6); PG8_BAR; PG8_MMA(1, 1, At, B1); PG8_BAR;
            }
        }
        if constexpr (ALIGN_EPI) { if (wr == 0) PG8_BAR; }
        if constexpr (!Epi::AFTER_DRAIN) { E(acc, cur, wr, wc, fr, fq); S.done(cur); }
        if (!has_next) break;
#pragma unroll
        for (int a = 0; a < 2; ++a)
#pragma unroll
            for (int b = 0; b < 2; ++b)
#pragma unroll
                for (int m = 0; m < 4; ++m)
#pragma unroll
                    for (int n = 0; n < 2; ++n) acc[a][b][m][n] = (f32x4){0.f, 0.f, 0.f, 0.f};
        cur = nxt; cA = nA; cB = nB; ++ui;
        if constexpr (ALIGN_EPI) { if (wr == 1) PG8_BAR; }
    }
    PG8_WAIT_V(0);
    if constexpr (!ALIGN_EPI) { if (wr == 0) PG8_BAR; }
    PG8_BAR;
    if constexpr (Epi::AFTER_DRAIN) { E.fused(acc, cur, wr, wc, fr, fq, lds, wid, lane); S.done(cur); }
#undef PG8_SA
#undef PG8_SB
#undef PG8_STAGE
#undef PG8_LDA
#undef PG8_LDB
#undef PG8_MMA
#undef PG8_WAIT_V
#undef PG8_WAIT_L
#undef PG8_BAR
#undef PG8_SCHED
}
}
using pg8::bf16_t; using pg8::bf16x8; using pg8::f32x4; using pg8::u32x4; using pg8::u32x2;
using pg8::cvt_pk_bf16; using pg8::bflo; using pg8::bfhi; using pg8::sigm; using pg8::gelu_t;
using namespace pg8;
#define LAS __attribute__((address_space(3)))
typedef LAS unsigned char* ldsp;
constexpr int S = 16384, NL = 4, NT = 512;
constexpr int LDS_BYTES = 147456;
constexpr size_t al256(size_t x) { return (x + 255) & ~(size_t)255; }
constexpr size_t WS_SSQ = 0;
constexpr size_t WS_CTR = WS_SSQ + 16 * (size_t)S * 4;
constexpr size_t WS_BIASP = WS_CTR + 1024;
constexpr size_t WS_BAR = al256(WS_BIASP + 16 * 256 * 4);
constexpr size_t WS_LSE = al256(WS_BAR + 16384);
constexpr size_t WS_ATOT = al256(WS_LSE + (size_t)12 * S * 4);
constexpr size_t WS_HEND = WS_ATOT + 256 * 768 * 4;
constexpr size_t WS_KC = WS_HEND + 256 * 768 * 4;
constexpr size_t WS_VCT = WS_KC + 3 * 1024 * 64 * 2;
constexpr size_t WS_WT = al256(WS_VCT + 3 * 1024 * 64 * 2);
constexpr size_t WT_W13A = 0, WT_W2A = WT_W13A + (size_t)5632 * 1024 * 2, WT_WIN = WT_W2A + (size_t)1024 * 2816 * 2, WT_LRU = WT_WIN + (size_t)8960 * 1024 * 2,
                 WT_C1K = WT_LRU + 6 * 256 * 128 * 2, WT_C1V = WT_C1K + 256 * 2048 * 2, WT_C2K = WT_C1V + 256 * 2048 * 2, WT_C2V = WT_C2K + 64 * 256 * 2,
                 WT_UA = WT_C2V + 64 * 256 * 2, WT_UB = WT_UA + 1024 * 768 * 2, WT_UC = WT_UB + 1024 * 768 * 2, WT_WO = WT_UC + 1024 * 256 * 2,
                 WT_W13B = WT_WO + 1024 * 1024 * 2, WT_W2B = WT_W13B + (size_t)5632 * 1024 * 2, WT_END = WT_W2B + (size_t)1024 * 2816 * 2;
constexpr size_t WS_XB = al256(WS_WT + WT_END);
constexpr size_t WS_YA = WS_XB + (size_t)S * 1024 * 2;
constexpr size_t WS_HLOC = WS_YA + (size_t)S * 768 * 2;
constexpr size_t WS_CUMP = WS_HLOC + (size_t)S * 768 * 2;
constexpr size_t WS_NSAO = WS_CUMP + (size_t)S * 768 * 2;
constexpr size_t WS_DILO = WS_NSAO + (size_t)S * 768 * 2;
constexpr size_t WS_VTS = WS_DILO + (size_t)S * 256 * 2;
constexpr size_t WS_VTW = WS_VTS + (size_t)3 * 64 * S * 2;
constexpr size_t WS_VTC = WS_VTW + (size_t)3 * 64 * S * 2;
constexpr size_t WS_MERGED = WS_VTS;
constexpr size_t WS_P = WS_VTC + (size_t)12 * 64 * S * 2;
constexpr size_t WS_HID = WS_P;
constexpr size_t WS_END = WS_P + (size_t)S * PW * 2;
static_assert((size_t)S * 1024 * 2 <= (size_t)18 * 64 * S * 2, "merged fits the VT region");

struct Args { const float* in[29]; float* out; unsigned char* ws; };
enum { I_X = 0, I_F1N, I_F1W1, I_F1W3, I_F1W2, I_MIXN, I_WIN, I_CONVW, I_CONVB, I_LRUWA, I_LRUBA, I_LRUWI, I_LRUBI, I_LAM, I_POSK, I_POSV,
       I_CK1, I_CK2, I_CV1, I_CV2, I_UPA, I_UPB, I_UPC, I_WOUT, I_F2N, I_F2W1, I_F2W3, I_F2W2, I_FINN };

__device__ __forceinline__ const float* inp(int i) {
    const __attribute__((address_space(4))) char* kp = (const __attribute__((address_space(4))) char*)__builtin_amdgcn_kernarg_segment_ptr();
    unsigned off = (unsigned)i * 8u; asm volatile("" : "+s"(off));
    const float* g = *(const float* const __attribute__((address_space(4)))*)(kp + off);
    return (const float*)(const __attribute__((address_space(1))) float*)g;
}
__device__ __forceinline__ float wave_sum(float v) {
#pragma unroll
    for (int o = 1; o < 64; o <<= 1) v += __shfl_xor(v, o);
    return v;
}
__device__ __forceinline__ f32x4 mfma16(bf16x8 a, bf16x8 b, f32x4 c) { return __builtin_amdgcn_mfma_f32_16x16x32_bf16(a, b, c, 0, 0, 0); }

#define XB_TMO      128
#define XB_XCNT(j)  (256  + 64 * (j))
#define XB_XSUB(j)  (1280 + 64 * (j))
#define XB_XGEN(j)  (2304 + 64 * (j))
#define XB_TOP      3328
#define XB_TOPGEN   3392
#define XCD_BAR_WORDS 3456
#define XB_SPIN_CAP (1u << 22)

__device__ __forceinline__ unsigned xb_ld(unsigned* p)              { return __hip_atomic_load(p, __ATOMIC_RELAXED, __HIP_MEMORY_SCOPE_AGENT); }
__device__ __forceinline__ unsigned xb_add(unsigned* p, unsigned v) { return __hip_atomic_fetch_add(p, v, __ATOMIC_RELAXED, __HIP_MEMORY_SCOPE_AGENT); }
__device__ __forceinline__ unsigned xb_xcc_id() { return (unsigned)__builtin_amdgcn_s_getreg((3 << 11) | 20) & 0xFu; }
#define XB_SPIN(cond, bar) do { unsigned _sp = 0; while (cond) { __builtin_amdgcn_s_sleep(1); \
    if ((++_sp & 255u) == 0u) { if (xb_ld(&(bar)[XB_TMO])) break; if (_sp > XB_SPIN_CAP) { atomicAdd(&(bar)[XB_TMO], 1u); break; } } } } while (0)

struct XcdBarrier {
    unsigned* bar; unsigned x;
    volatile LAS unsigned* st;
};

__device__ __forceinline__ XcdBarrier xcd_barrier_post(unsigned* bar, volatile LAS unsigned* st) {
    XcdBarrier b; b.bar = bar; b.x = xb_xcc_id(); b.st = st;
    if (threadIdx.x == 0) (void)xb_add(&bar[XB_XCNT(b.x)], 1u);
    return b;
}
__device__ __forceinline__ void xcd_barrier_complete(unsigned* bar, unsigned x, unsigned& nloc, unsigned& nx) {
    const unsigned G = gridDim.x * gridDim.y * gridDim.z;
    unsigned sum, cnt, mine, sp = 0u;
    for (;;) {
        sum = 0u; cnt = 0u; mine = 0u;
#pragma unroll
        for (unsigned j = 0; j < 16; ++j) { const unsigned c = xb_ld(&bar[XB_XCNT(j)]); sum += c; cnt += (c > 0u) ? 1u : 0u; mine = (j == x) ? c : mine; }
        if (sum == G) break;
        __builtin_amdgcn_s_sleep(1);
        if ((++sp & 255u) == 0u) { if (xb_ld(&bar[XB_TMO])) break; if (sp > XB_SPIN_CAP) { atomicAdd(&bar[XB_TMO], 1u); break; } }
    }
    nloc = mine > 0u ? mine : 1u; nx = cnt > 0u ? cnt : 1u;
}

__device__ __forceinline__ void xcd_barrier(const XcdBarrier& b) {
    asm volatile("s_waitcnt vmcnt(0)" ::: "memory");
    __syncthreads();
    if (threadIdx.x == 0) {
        unsigned* bar = b.bar;
        __builtin_amdgcn_s_waitcnt(0);
        unsigned nloc = b.st[0], nx = b.st[1];
        if (nloc == 0u) { xcd_barrier_complete(bar, b.x, nloc, nx); b.st[0] = nloc; b.st[1] = nx; }
        const unsigned old = xb_add(&bar[XB_XSUB(b.x)], 1u);
        const unsigned gen = old / nloc;
        if (old + 1u == (gen + 1u) * nloc) {
            __builtin_amdgcn_fence(__ATOMIC_RELEASE, "agent");
            asm volatile("s_waitcnt vmcnt(0)" ::: "memory");
            const unsigned og = xb_add(&bar[XB_TOP], 1u);
            const unsigned tg = og / nx;
            if (og + 1u == (tg + 1u) * nx) xb_add(&bar[XB_TOPGEN], 1u);
            else XB_SPIN(xb_ld(&bar[XB_TOPGEN]) == tg, bar);
            __builtin_amdgcn_fence(__ATOMIC_ACQUIRE, "agent");
            xb_add(&bar[XB_XGEN(b.x)], 1u);
            asm volatile("s_waitcnt vmcnt(0)" ::: "memory");
        } else {
            XB_SPIN(xb_ld(&bar[XB_XGEN(b.x)]) == gen, bar);
            __builtin_amdgcn_fence(__ATOMIC_ACQUIRE, "agent");
            asm volatile("s_waitcnt vmcnt(0)" ::: "memory");
        }
    }
    __syncthreads();
}

template <class RowF>
__device__ __forceinline__ void tr_item(const float* src, int ldn, int nsrc, const float* gk, bf16_t* WT, int K, int item, int nblk, LAS float* scr, int lane, RowF rowmap) {
    const int kb = item / nblk, nb = item % nblk, k0 = 64 * kb, n0 = 32 * nb;
    const int nq = n0 + 4 * (lane & 7); const bool okc = nq + 3 < nsrc; const float* cp = src + (okc ? nq : 0);
#pragma unroll
    for (int i = 0; i < 8; ++i) { const int kk = 8 * i + (lane >> 3); f32x4 v = okc ? *(const f32x4*)(cp + (size_t)(k0 + kk) * ldn) : (f32x4){0.f, 0.f, 0.f, 0.f}; if (gk) v = v * gk[k0 + kk];
        LAS float* d = scr + kk * 33 + 4 * (lane & 7); d[0] = v[0]; d[1] = v[1]; d[2] = v[2]; d[3] = v[3]; }
    asm volatile("s_waitcnt lgkmcnt(0)" ::: "memory");
    const int c = lane & 7;
#pragma unroll
    for (int j = 0; j < 4; ++j) { const int n = (lane >> 3) + 8 * j; const LAS float* s = scr + (8 * c) * 33 + n;
        u32x4 o; o.x = cvt_pk_bf16(s[0 * 33], s[1 * 33]); o.y = cvt_pk_bf16(s[2 * 33], s[3 * 33]); o.z = cvt_pk_bf16(s[4 * 33], s[5 * 33]); o.w = cvt_pk_bf16(s[6 * 33], s[7 * 33]);
        if (n0 + n < nsrc) *(u32x4*)(WT + (size_t)rowmap(n0 + n) * K + k0 + 8 * c) = o; }
    asm volatile("s_waitcnt lgkmcnt(0)" ::: "memory");
}
__device__ __forceinline__ int rm_id(int n) { return n; }
constexpr int PN1 = 16 * 88, PN2 = 44 * 32, PNIN = 16 * 278, PNLR = 6 * 8, PNC1 = 32 * 8, PNC2 = 4 * 2, PNUA = 12 * 32, PNUC = 4 * 32, PNWO = 16 * 32;
constexpr int PREP_GA = 2 * PN1 + PN2 + PNIN, PREP_GB = 2 * PNLR + 2 * PNC1 + 2 * PNC2 + 16 * 8 + 8, PREP_GC = 2 * PNUA + PNUC + PNWO + 2 * PN1 + PN2;
constexpr int PREP_GA_B = (PREP_GA + 7) / 8, PREP_GB_B = (PREP_GB + 7) / 8, PREP_GC_B = (PREP_GC + 7) / 8;
__device__ __forceinline__ void prep_wave_item(unsigned char* ws, int l, int grp, int r, LAS float* scr, int lane) {
    unsigned char* wt = ws + WS_WT;
    auto rm13a = [](int j) { return (j >> 2) * 8 + (j & 3); };
    auto rm13b = [](int j) { return (j >> 2) * 8 + 4 + (j & 3); };
    auto rmin = [](int o) { return o < 2304 ? o : o < 3456 ? o - 2304 + 7680 : o < 3492 ? o - 3456 + 8832 : o < 5796 ? o - 3492 + 2304 : o - 5796 + 4608; };
    if (grp == 0) {
        if (r < PN1) { tr_item(inp(I_F1W1) + (size_t)l * DM * DFF, DFF, DFF, inp(I_F1N) + l * DM, (bf16_t*)(wt + WT_W13A), 1024, r, 88, scr, lane, rm13a); return; } r -= PN1;
        if (r < PN1) { tr_item(inp(I_F1W3) + (size_t)l * DM * DFF, DFF, DFF, inp(I_F1N) + l * DM, (bf16_t*)(wt + WT_W13A), 1024, r, 88, scr, lane, rm13b); return; } r -= PN1;
        if (r < PN2) { tr_item(inp(I_F1W2) + (size_t)l * DFF * DM, DM, DM, nullptr, (bf16_t*)(wt + WT_W2A), 2816, r, 32, scr, lane, rm_id); return; } r -= PN2;
        if (r < PNIN) { tr_item(inp(I_WIN) + (size_t)l * DM * 8868, 8868, 8868, inp(I_MIXN) + l * DM, (bf16_t*)(wt + WT_WIN), 1024, r, 278, scr, lane, rmin); }
    } else if (grp == 1) {
        if (r < PNLR) { const int b = r / 8, rr = r % 8; tr_item(inp(I_LRUWA) + (size_t)l * 98304 + b * 16384, 128, 128, nullptr, (bf16_t*)(wt + WT_LRU) + b * 256 * 128, 128, rr, 4, scr, lane, rm_id); return; } r -= PNLR;
        if (r < PNLR) { const int b = r / 8, rr = r % 8; tr_item(inp(I_LRUWI) + (size_t)l * 98304 + b * 16384, 128, 128, nullptr, (bf16_t*)(wt + WT_LRU) + b * 256 * 128 + 128 * 128, 128, rr, 4, scr, lane, rm_id); return; } r -= PNLR;
        if (r < PNC1) { tr_item(inp(I_CK1) + (size_t)l * 2048 * 256, 256, 256, nullptr, (bf16_t*)(wt + WT_C1K), 2048, r, 8, scr, lane, rm_id); return; } r -= PNC1;
        if (r < PNC1) { tr_item(inp(I_CV1) + (size_t)l * 2048 * 256, 256, 256, nullptr, (bf16_t*)(wt + WT_C1V), 2048, r, 8, scr, lane, rm_id); return; } r -= PNC1;
        if (r < PNC2) { tr_item(inp(I_CK2) + (size_t)l * 256 * 64, 64, 64, nullptr, (bf16_t*)(wt + WT_C2K), 256, r, 2, scr, lane, rm_id); return; } r -= PNC2;
        if (r < PNC2) { tr_item(inp(I_CV2) + (size_t)l * 256 * 64, 64, 64, nullptr, (bf16_t*)(wt + WT_C2V), 256, r, 2, scr, lane, rm_id); return; } r -= PNC2;
        if (r < 128) {
            const int pb = r >> 3, wv = r & 7, kv = pb >> 3, part = pb & 7;
            if (lane < 32) { const int j = wv * 32 + lane;
                const float* pos = inp(kv ? I_POSV : I_POSK) + (size_t)l * 2048 + part * 256; const float* w1 = inp(kv ? I_CV1 : I_CK1) + (size_t)l * 2048 * 256 + (size_t)part * 256 * 256 + j;
                float s = 0.f;
#pragma unroll 8
                for (int kk = 0; kk < 256; ++kk) s += pos[kk] * w1[(size_t)kk * 256];
                ((float*)(ws + WS_BIASP))[pb * 256 + j] = s; }
            return; } r -= 128;
        if (r < 8) {
            u32x4* z = (u32x4*)((bf16_t*)(wt + WT_WIN) + (size_t)8868 * 1024); const int nz = 92 * 1024 * 2 / 16;
            unsigned zz = 0u; asm volatile("" : "+v"(zz));
            for (int i = r * 64 + lane; i < nz; i += 512) z[i] = (u32x4){zz, zz, zz, zz}; }
    } else {
        if (r < PNUA) { tr_item(inp(I_UPA) + (size_t)l * 768 * 1024, 1024, 1024, nullptr, (bf16_t*)(wt + WT_UA), 768, r, 32, scr, lane, rm_id); return; } r -= PNUA;
        if (r < PNUA) { tr_item(inp(I_UPB) + (size_t)l * 768 * 1024, 1024, 1024, nullptr, (bf16_t*)(wt + WT_UB), 768, r, 32, scr, lane, rm_id); return; } r -= PNUA;
        if (r < PNUC) { tr_item(inp(I_UPC) + (size_t)l * 256 * 1024, 1024, 1024, nullptr, (bf16_t*)(wt + WT_UC), 256, r, 32, scr, lane, rm_id); return; } r -= PNUC;
        if (r < PNWO) { tr_item(inp(I_WOUT) + (size_t)l * 1024 * 1024, 1024, 1024, nullptr, (bf16_t*)(wt + WT_WO), 1024, r, 32, scr, lane, rm_id); return; } r -= PNWO;
        if (r < PN1) { tr_item(inp(I_F2W1) + (size_t)l * DM * DFF, DFF, DFF, inp(I_F2N) + l * DM, (bf16_t*)(wt + WT_W13B), 1024, r, 88, scr, lane, rm13a); return; } r -= PN1;
        if (r < PN1) { tr_item(inp(I_F2W3) + (size_t)l * DM * DFF, DFF, DFF, inp(I_F2N) + l * DM, (bf16_t*)(wt + WT_W13B), 1024, r, 88, scr, lane, rm13b); return; } r -= PN1;
        if (r < PN2) { tr_item(inp(I_F2W2) + (size_t)l * DFF * DM, DM, DM, nullptr, (bf16_t*)(wt + WT_W2B), 2816, r, 32, scr, lane, rm_id); }
    }
}
__device__ __forceinline__ void prep_block_item(unsigned char* ws, int l, int grp, int bitem, ldsp lds, int tid) {
    asm volatile("" : "+v"(tid));
    const int lane = tid & 63, wave = __builtin_amdgcn_readfirstlane(tid >> 6);
    const int r = bitem * 8 + wave; const int cnt = grp == 0 ? PREP_GA : grp == 1 ? PREP_GB : PREP_GC;
    if (r < cnt) prep_wave_item(ws, l, grp, r, (LAS float*)(lds + wave * 8448), lane);
}
__device__ __forceinline__ void prep_phase(unsigned char* ws, int l, int grp, ldsp lds, int tid) {
    const int nb = grp == 0 ? PREP_GA_B : grp == 1 ? PREP_GB_B : PREP_GC_B;
    for (int b = blockIdx.x; b < nb; b += gridDim.x) prep_block_item(ws, l, grp, b, lds, tid);
}

struct FState { float m, l; f32x4 o[4]; };
__device__ __forceinline__ void fs_init(FState& st) { st.m = -1e30f; st.l = 0.f;
#pragma unroll
    for (int i = 0; i < 4; ++i) st.o[i] = (f32x4){0.f, 0.f, 0.f, 0.f}; }
constexpr int KV_BUF = 16384, NKVB = 3;
__device__ __forceinline__ int k_swz(int row) { return ((row >> 1) & 7) ^ (((row >> 4) & 1) << 1); }
struct KvOff { int k[2][2]; int v[2]; };
__device__ __forceinline__ KvOff kv_offsets(int c, int q) { KvOff o; const int rb = 8 * (c >> 2) + (c & 3);
#pragma unroll
    for (int b = 0; b < 2; ++b)
#pragma unroll
        for (int ks = 0; ks < 2; ++ks) { const int row = rb + 4 * b; o.k[ks][b] = row * 128 + (((ks * 4 + q) ^ k_swz(row)) * 16); }
#pragma unroll
    for (int k2 = 0; k2 < 2; ++k2) o.v[k2] = 8192 + c * 128 + (((4 * k2 + q) ^ ((c >> 1) & 7)) * 16);
    return o; }
__device__ __forceinline__ void qk_tile(ldsp B, const KvOff& ko, const bf16x8 (&qf)[2], f32x4 (&s)[4], f32x4 cinit) {
#pragma unroll
    for (int kt = 0; kt < 4; ++kt) { const bf16x8 a0 = *(const LAS bf16x8*)(B + ko.k[0][kt & 1] + (kt >> 1) * 4096), a1 = *(const LAS bf16x8*)(B + ko.k[1][kt & 1] + (kt >> 1) * 4096);
        s[kt] = mfma16(a0, qf[0], cinit); s[kt] = mfma16(a1, qf[1], s[kt]); }
}
#define KLOC(kt, r) (32 * ((kt) >> 1) + 4 * ((kt) & 1) + (r))
__device__ __forceinline__ void pv_tile(ldsp B, const KvOff& ko, const f32x4 (&p)[4], f32x4 (&o)[4], bool colok = true) {
#pragma unroll
    for (int k2 = 0; k2 < 2; ++k2) {
        u32x4 pw; pw.x = cvt_pk_bf16(p[2 * k2][0], p[2 * k2][1]); pw.y = cvt_pk_bf16(p[2 * k2][2], p[2 * k2][3]); pw.z = cvt_pk_bf16(p[2 * k2 + 1][0], p[2 * k2 + 1][1]); pw.w = cvt_pk_bf16(p[2 * k2 + 1][2], p[2 * k2 + 1][3]);
        pw.x = colok ? pw.x : 0u; pw.y = colok ? pw.y : 0u; pw.z = colok ? pw.z : 0u; pw.w = colok ? pw.w : 0u;
        const bf16x8 pb = __builtin_bit_cast(bf16x8, pw);
#pragma unroll
        for (int dt = 0; dt < 4; ++dt) o[dt] = mfma16(*(const LAS bf16x8*)(B + ko.v[k2] + dt * 2048), pb, o[dt]); }
}
__device__ __forceinline__ float quad_sum(float v) {
    v += __int_as_float(__builtin_amdgcn_update_dpp(0, __float_as_int(v), 0xB1, 0xF, 0xF, true));
    v += __int_as_float(__builtin_amdgcn_update_dpp(0, __float_as_int(v), 0x4E, 0xF, 0xF, true));
    return v; }
__device__ __forceinline__ float colmax4(float m) {
    { const auto rr = __builtin_amdgcn_permlane16_swap(__float_as_uint(m), __float_as_uint(m), false, false); m = fmaxf(__uint_as_float(rr[0]), __uint_as_float(rr[1])); }
    { const auto rr = __builtin_amdgcn_permlane32_swap(__float_as_uint(m), __float_as_uint(m), false, false); m = fmaxf(__uint_as_float(rr[0]), __uint_as_float(rr[1])); }
    return m;
}
template <int MK, class MaskF>
__device__ __forceinline__ void flash_step(ldsp B, const KvOff& ko, const bf16x8 (&qf)[2], FState& st, bool colok, MaskF mk) {
    const bool fresh = st.m <= -1e29f; const float mu = fresh ? 0.f : st.m;
    const f32x4 negm = (f32x4){-mu, -mu, -mu, -mu};
    f32x4 s[4]; qk_tile(B, ko, qf, s, negm);
    if (MK == 1) {
#pragma unroll
        for (int kt = 0; kt < 4; ++kt)
#pragma unroll
            for (int r = 0; r < 4; ++r) s[kt][r] = mk(KLOC(kt, r)) ? s[kt][r] : -1e30f; }
    float mx = fmaxf(fmaxf(s[0][0], s[0][1]), fmaxf(s[0][2], s[0][3]));
#pragma unroll
    for (int kt = 1; kt < 4; ++kt) mx = fmaxf(fmaxf(mx, s[kt][0]), fmaxf(fmaxf(s[kt][1], s[kt][2]), s[kt][3]));
    if (MK == 2) mx = colok ? mx : -1e30f;
    const bool need = fresh ? (mx > -1e29f) : (mx > 8.0f);
    if (__any(need)) {
        const float mc = colmax4(mx);
        const bool none = fresh && mc <= -1e29f;
        const float delta = none ? 0.f : (fresh ? mc : fmaxf(mc, 0.f));
        st.m = none ? st.m : mu + delta;
        const float alpha = __builtin_amdgcn_exp2f(-delta); st.l *= alpha;
#pragma unroll
        for (int dt = 0; dt < 4; ++dt) st.o[dt] = st.o[dt] * alpha;
#pragma unroll
        for (int kt = 0; kt < 4; ++kt) s[kt] = s[kt] - delta;
    }
    float rs = 0.f;
#pragma unroll
    for (int kt = 0; kt < 4; ++kt)
#pragma unroll
        for (int r = 0; r < 4; ++r) s[kt][r] = __builtin_amdgcn_exp2f(s[kt][r]);
#pragma unroll
    for (int kt = 0; kt < 4; ++kt) rs += (s[kt][0] + s[kt][1]) + (s[kt][2] + s[kt][3]);
    st.l += (MK == 2 && !colok) ? 0.f : rs;
    pv_tile(B, ko, s, st.o, (MK == 2) ? colok : true);
}
__device__ __forceinline__ void glds16(const void* gsrc, unsigned lds_dst) { unsigned keep;
    asm volatile("s_mov_b32 %0, m0\n\ts_mov_b32 m0, %2\n\ts_nop 0\n\tglobal_load_lds_dwordx4 %1, off\n\ts_mov_b32 m0, %0" : "=&s"(keep) : "v"(gsrc), "s"(lds_dst) : "memory"); }
template <class BodyF>
__device__ __forceinline__ void kv_loop(ldsp lds, const bf16_t* Kg, size_t kpitch, int kmaxrow, const bf16_t* VTg, size_t vtpitch, int kb0, int kb1, int tid, BodyF body) {
    asm volatile("" : "+v"(tid));
    const int r = tid >> 3, sc = (tid & 7) ^ ((r >> 1) & 7), sck = (tid & 7) ^ k_swz(r);
    const unsigned ldsw = (unsigned)__builtin_amdgcn_readfirstlane((int)(unsigned)(unsigned long long)lds + (tid >> 6) * 1024);
    const bf16_t* vsrc = VTg + (size_t)r * vtpitch + sc * 8;
    auto issue = [&](int kb, unsigned slot) { int row = kb * 64 + r; row = row < kmaxrow ? row : kmaxrow;
        glds16(Kg + (size_t)row * kpitch + sck * 8, ldsw + slot); glds16(vsrc + kb * 64, ldsw + slot + 8192); };
    if (kb0 < kb1) issue(kb0, 0u);
    if (kb0 + 1 < kb1) issue(kb0 + 1, (unsigned)KV_BUF);
    unsigned cs = 0u, ns = 2u * KV_BUF;
    for (int kb = kb0; kb < kb1; ++kb) {
        if (kb + 1 < kb1) asm volatile("s_waitcnt vmcnt(2) lgkmcnt(0)\n\ts_barrier" ::: "memory");
        else asm volatile("s_waitcnt vmcnt(0) lgkmcnt(0)\n\ts_barrier" ::: "memory");
        if (kb + 2 < kb1) issue(kb + 2, ns);
        body(kb, lds + cs);
        cs = cs == 2u * KV_BUF ? 0u : cs + KV_BUF; ns = ns == 2u * KV_BUF ? 0u : ns + KV_BUF;
    }
    asm volatile("s_waitcnt vmcnt(0) lgkmcnt(0)\n\ts_barrier" ::: "memory");
}
template <int CH, class BodyF>
__device__ __forceinline__ void kv_loop_chunked(ldsp lds, const bf16_t* Kg, size_t kpitch, int kmaxrow, const bf16_t* VTg, size_t vtpitch, int kb0, int kb1, int tid, BodyF body) {
    asm volatile("" : "+v"(tid));
    const int r = tid >> 3, sc = (tid & 7) ^ ((r >> 1) & 7);
    const unsigned ldsw = (unsigned)__builtin_amdgcn_readfirstlane((int)(unsigned)(unsigned long long)lds + (tid >> 6) * 1024);
    const bf16_t* vsrc = VTg + (size_t)r * vtpitch + sc * 8;
    auto issue_chunk = [&](int kbc, unsigned half) {
#pragma unroll
        for (int j = 0; j < CH; ++j) { const int kb = kbc + j; if (kb < kb1) { int row = kb * 64 + r; row = row < kmaxrow ? row : kmaxrow; const unsigned slot = half + (unsigned)j * KV_BUF;
            glds16(Kg + (size_t)row * kpitch + sc * 8, ldsw + slot); glds16(vsrc + kb * 64, ldsw + slot + 8192); } } };
    if (kb0 < kb1) issue_chunk(kb0, 0u);
    unsigned half = 0u;
    for (int kbc = kb0; kbc < kb1; kbc += CH) {
        asm volatile("s_waitcnt vmcnt(0) lgkmcnt(0)\n\ts_barrier" ::: "memory");
        if (kbc + CH < kb1) issue_chunk(kbc + CH, half ^ (unsigned)(CH * KV_BUF));
#pragma unroll 1
        for (int j = 0; j < CH; ++j) { const int kb = kbc + j; if (kb < kb1) body(kb, lds + half + j * KV_BUF); }
        half ^= (unsigned)(CH * KV_BUF);
    }
    asm volatile("s_waitcnt vmcnt(0) lgkmcnt(0)\n\ts_barrier" ::: "memory");
}
__device__ __forceinline__ float fs_ltot(const FState& st) { float l = st.l; l += __shfl_xor(l, 16); l += __shfl_xor(l, 32); return l; }

constexpr int NG = 2;
template <int MODE>
__device__ __forceinline__ void nsa_item(unsigned char* ws, ldsp lds, int tile, int kh, int tid) {
    asm volatile("" : "+v"(tid));
    const int lane = tid & 63, wave = __builtin_amdgcn_readfirstlane(tid >> 6), c = lane & 15, q = lane >> 4;
    const int t0 = tile * 64, tk = c >> 2, g = c & 3, hq = kh * 4 + g, cur = tile;
    const bf16_t* P = (const bf16_t*)(ws + WS_P);
    LAS float* imp = (LAS float*)(lds + NKVB * KV_BUF) + wave * (NG * 4 * 256);
    LAS unsigned* selm = (LAS unsigned*)(lds + 8 * KV_BUF) + wave * (NG * 4 * 8);
    const KvOff ko = kv_offsets(c, q);
    int t[NG]; bf16x8 qf[NG][2];
#pragma unroll
    for (int gi = 0; gi < NG; ++gi) { t[gi] = t0 + wave * (4 * NG) + gi * 4 + tk;
#pragma unroll
        for (int ks = 0; ks < 2; ++ks) qf[gi][ks] = *(const bf16x8*)(P + (size_t)t[gi] * PW + PC_BQ + hq * 64 + ks * 32 + q * 8); }
    const bf16_t* KC = (const bf16_t*)(ws + WS_KC) + (size_t)kh * 1024 * 64; const bf16_t* VCT = (const bf16_t*)(ws + WS_VCT) + (size_t)kh * 64 * 1024;
    const int nkbc = (t0 >> 10) + 1;
    float cm[NG], cl[NG];
#pragma unroll
    for (int gi = 0; gi < NG; ++gi) { cm[gi] = -1e30f; cl[gi] = 0.f; }
    if (MODE & 1) kv_loop(lds, KC, 64, 1023, VCT, 1024, 0, nkbc, tid, [&](int kb, ldsp B) {
#pragma unroll
        for (int gi = 0; gi < NG; ++gi) {
            f32x4 s[4]; qk_tile(B, ko, qf[gi], s, (f32x4){0.f, 0.f, 0.f, 0.f}); float mx = -1e30f; const int lim = ((t[gi] - 31) >> 4) - kb * 64 - 8 * q;
#pragma unroll
            for (int kt = 0; kt < 4; ++kt)
#pragma unroll
                for (int r = 0; r < 4; ++r) { const bool v = (KLOC(kt, r) <= lim); s[kt][r] = v ? s[kt][r] : -1e30f; mx = fmaxf(mx, s[kt][r]); }
            mx = colmax4(mx);
            const float mn = fmaxf(cm[gi], mx); const float alpha = __builtin_amdgcn_exp2f(cm[gi] - mn); cm[gi] = mn; float rs = 0.f;
#pragma unroll
            for (int kt = 0; kt < 4; ++kt)
#pragma unroll
                for (int r = 0; r < 4; ++r) rs += (s[kt][r] > -1e29f) ? __builtin_amdgcn_exp2f(s[kt][r] - mn) : 0.f;
            cl[gi] = cl[gi] * alpha + rs; }
    });
#pragma unroll
    for (int gi = 0; gi < NG; ++gi) { float lt = cl[gi]; lt += __shfl_xor(lt, 16); lt += __shfl_xor(lt, 32); cl[gi] = lt > 0.f ? 1.f / lt : 0.f; }
    {
    f32x4 fin[NG][4];
#pragma unroll
    for (int gi = 0; gi < NG; ++gi)
#pragma unroll
        for (int i = 0; i < 4; ++i) fin[gi][i] = (f32x4){0.f, 0.f, 0.f, 0.f};
    if (MODE & 1) kv_loop(lds, KC, 64, 1023, VCT, 1024, 0, nkbc, tid, [&](int kb, ldsp B) {
#pragma unroll
        for (int gi = 0; gi < NG; ++gi) {
            f32x4 s[4]; qk_tile(B, ko, qf[gi], s, (f32x4){0.f, 0.f, 0.f, 0.f}); const int lim = ((t[gi] - 31) >> 4) - kb * 64 - 8 * q;
#pragma unroll
            for (int kt = 0; kt < 4; ++kt) { float ps = 0.f;
#pragma unroll
                for (int r = 0; r < 4; ++r) { const bool v = (KLOC(kt, r) <= lim); const float p = v ? __builtin_amdgcn_exp2f(s[kt][r] - cm[gi]) * cl[gi] : 0.f; s[kt][r] = p; ps += p; }
                ps = quad_sum(ps);
                if (g == 0) imp[(gi * 4 + tk) * 256 + kb * 16 + 8 * (kt >> 1) + 2 * q + (kt & 1)] = ps; }
            pv_tile(B, ko, s, fin[gi]); }
    });
#pragma unroll
    for (int gi = 0; gi < NG; ++gi) { const float g0 = sigm(bflo((unsigned)P[(size_t)t[gi] * PW + PC_BG + hq * 3])); bf16_t* O = (bf16_t*)(ws + WS_NSAO) + (size_t)t[gi] * 768 + hq * 64;
#pragma unroll
        for (int dt = 0; dt < 4; ++dt) { const f32x4 v = fin[gi][dt] * g0; u32x2 w; w.x = cvt_pk_bf16(v[0], v[1]); w.y = cvt_pk_bf16(v[2], v[3]); if ((MODE & 16) || v[0] == 12345.678f) *(u32x2*)(O + dt * 16 + 4 * q) = w; } }
    }
    asm volatile("s_waitcnt lgkmcnt(0)" ::: "memory");
    if (MODE & 2)
#pragma unroll 2
    for (int tt = 0; tt < NG * 4; ++tt) {
        LAS float* im = imp + tt * 256;
        unsigned vb[4];
#pragma unroll
        for (int i = 0; i < 4; ++i) { const int n = lane + 64 * i; const float f = im[n]; vb[i] = (n <= cur) ? ((n == 0 || n == cur) ? 0x4e6e6b28u   : __float_as_uint(f)) : 0u; }
        unsigned long long selb[4];
        if (cur < 16) {
#pragma unroll
            for (int i = 0; i < 4; ++i) selb[i] = __ballot(lane + 64 * i <= cur);
        } else {
            unsigned thr = 0u; bool exact = false;
            for (int b = 30; b >= 0; --b) { const unsigned cand = thr | (1u << b); int cnt = 0;
#pragma unroll
                for (int i = 0; i < 4; ++i) cnt += __builtin_popcountll(__ballot(vb[i] >= cand));
                if (cnt >= 16) { thr = cand; if (cnt == 16) { exact = true; break; } } }
            if (exact) {
#pragma unroll
                for (int i = 0; i < 4; ++i) selb[i] = __ballot(vb[i] >= thr);
            } else {
            int ngt = 0;
#pragma unroll
            for (int i = 0; i < 4; ++i) ngt += __builtin_popcountll(__ballot(vb[i] > thr));
            int need = 16 - ngt;
#pragma unroll
            for (int i = 0; i < 4; ++i) { const unsigned long long eq = __ballot(vb[i] == thr && lane + 64 * i <= cur); const unsigned long long below = eq & ((1ull << lane) - 1ull);
                const bool take = (vb[i] == thr) && (lane + 64 * i <= cur) && ((int)__builtin_popcountll(below) < need);
                selb[i] = __ballot((vb[i] > thr) || take); need -= (int)__builtin_popcountll(eq); need = need < 0 ? 0 : need; }
            }
        }
#pragma unroll
        for (int i = 0; i < 4; ++i) if (lane == 0) { selm[tt * 8 + 2 * i] = (unsigned)selb[i]; selm[tt * 8 + 2 * i + 1] = (unsigned)(selb[i] >> 32); }
    }
    asm volatile("s_waitcnt lgkmcnt(0)" ::: "memory");
    if (MODE & 4) {
        LAS unsigned* sm_all = (LAS unsigned*)(lds + 8 * KV_BUF);
        ldsp QT = lds;
        LAS int* OACC = (LAS int*)(lds + 49152);
        LAS int* LACC = (LAS int*)(lds + 49152 + 256 * 272); LAS float* MREF = (LAS float*)(LACC + 256);
        const bf16_t* Kg = P + PC_KS + kh * 64; const bf16_t* VTg = (const bf16_t*)(ws + WS_VTS) + (size_t)kh * 64 * S;
        __syncthreads();
#pragma unroll
        for (int gi = 0; gi < NG; ++gi) { const int row = (wave * (4 * NG) + gi * 4 + tk) * 4 + g, sw = (row >> 1) & 7;
#pragma unroll
            for (int ks = 0; ks < 2; ++ks) *(LAS bf16x8*)(QT + row * 128 + (((ks * 4 + q) ^ sw) * 16)) = qf[gi][ks]; }
        for (int i = tid; i < 256 * 68 + 256; i += NT) OACC[i] = 0;
        __syncthreads();
        auto block_step = [&](int kb, const bf16x8 (&kf)[4][2], const u32x4 (&vf)[4][2], int rowv, bool colok, bool diag, int tq, bool setref) {
            const int sw = (rowv >> 1) & 7;
            const bf16x8 q0 = *(const LAS bf16x8*)(QT + rowv * 128 + ((q ^ sw) * 16)), q1 = *(const LAS bf16x8*)(QT + rowv * 128 + (((4 + q) ^ sw) * 16));
            const float cin = setref ? 0.f : 10.f - MREF[rowv];
            const f32x4 cinit = (f32x4){cin, cin, cin, cin};
            f32x4 s[4];
#pragma unroll
            for (int kt = 0; kt < 4; ++kt) { s[kt] = mfma16(kf[kt][0], q0, cinit); s[kt] = mfma16(kf[kt][1], q1, s[kt]); }
            if (diag) { const int lim = tq - kb * 64 - 8 * q;
#pragma unroll
                for (int kt = 0; kt < 4; ++kt)
#pragma unroll
                    for (int r = 0; r < 4; ++r) s[kt][r] = (32 * (kt >> 1) + 4 * (kt & 1) + r <= lim) ? s[kt][r] : -1e30f; }
            if (setref) { float mx = fmaxf(fmaxf(s[0][0], s[0][1]), fmaxf(s[0][2], s[0][3]));
#pragma unroll
                for (int kt = 1; kt < 4; ++kt) mx = fmaxf(fmaxf(mx, s[kt][0]), fmaxf(fmaxf(s[kt][1], s[kt][2]), s[kt][3]));
                const float mref = colmax4(mx); if (q == 0) MREF[rowv] = mref;
                const float d = mref - 10.f;
#pragma unroll
                for (int kt = 0; kt < 4; ++kt) s[kt] = s[kt] - d; }
            float rs = 0.f;
#pragma unroll
            for (int kt = 0; kt < 4; ++kt) {
#pragma unroll
                for (int r = 0; r < 4; ++r) s[kt][r] = __builtin_amdgcn_exp2f(s[kt][r]);
                rs += (s[kt][0] + s[kt][1]) + (s[kt][2] + s[kt][3]); }
            { const auto rr = __builtin_amdgcn_permlane16_swap(__float_as_uint(rs), __float_as_uint(rs), false, false); rs = __uint_as_float(rr[0]) + __uint_as_float(rr[1]); }
            { const auto rr = __builtin_amdgcn_permlane32_swap(__float_as_uint(rs), __float_as_uint(rs), false, false); rs = __uint_as_float(rr[0]) + __uint_as_float(rr[1]); }
            if (q == 0 && colok) __hip_atomic_fetch_add(LACC + rowv, __float2int_rn(rs), __ATOMIC_RELAXED, __HIP_MEMORY_SCOPE_WORKGROUP);
            f32x4 o[4];
#pragma unroll
            for (int dt = 0; dt < 4; ++dt) o[dt] = (f32x4){0.f, 0.f, 0.f, 0.f};
#pragma unroll
            for (int k2 = 0; k2 < 2; ++k2) { u32x4 pw; pw.x = cvt_pk_bf16(s[2 * k2][0], s[2 * k2][1]); pw.y = cvt_pk_bf16(s[2 * k2][2], s[2 * k2][3]); pw.z = cvt_pk_bf16(s[2 * k2 + 1][0], s[2 * k2 + 1][1]); pw.w = cvt_pk_bf16(s[2 * k2 + 1][2], s[2 * k2 + 1][3]);
                const bf16x8 pb = __builtin_bit_cast(bf16x8, pw);
#pragma unroll
                for (int dt = 0; dt < 4; ++dt) o[dt] = mfma16(__builtin_bit_cast(bf16x8, vf[dt][k2]), pb, o[dt]); }
            if (colok) {
#pragma unroll
                for (int dt = 0; dt < 4; ++dt)
#pragma unroll
                    for (int r = 0; r < 4; ++r) { if (MODE & 32) OACC[rowv * 68 + (dt * 4 + r) * 4 + q] = __float2int_rn(o[dt][r]); else __hip_atomic_fetch_add(OACC + rowv * 68 + (dt * 4 + r) * 4 + q, __float2int_rn(o[dt][r]), __ATOMIC_RELAXED, __HIP_MEMORY_SCOPE_WORKGROUP); } }
        };
        auto load_kv = [&](int kb, bf16x8 (&kf)[4][2], u32x4 (&vf)[4][2]) {
#pragma unroll
            for (int kt = 0; kt < 4; ++kt)
#pragma unroll
                for (int ks = 0; ks < 2; ++ks) kf[kt][ks] = *(const bf16x8*)(Kg + (size_t)(kb * 64 + 32 * (kt >> 1) + 8 * (c >> 2) + 4 * (kt & 1) + (c & 3)) * PW + ks * 32 + q * 8);
#pragma unroll
            for (int dt = 0; dt < 4; ++dt)
#pragma unroll
                for (int k2 = 0; k2 < 2; ++k2) vf[dt][k2] = *(const u32x4*)(VTg + (size_t)(dt * 16 + c) * S + kb * 64 + 32 * k2 + 8 * q); };
        { bf16x8 kf[4][2]; u32x4 vf[4][2];
            load_kv(cur, kf, vf);
#pragma unroll
            for (int gi = 0; gi < NG; ++gi) block_step(cur, kf, vf, (wave * (4 * NG) + gi * 4 + tk) * 4 + g, true, true, t[gi], true);
            if (cur > 0) { asm volatile("s_waitcnt lgkmcnt(0)" ::: "memory"); load_kv(0, kf, vf);
#pragma unroll
                for (int gi = 0; gi < NG; ++gi) block_step(0, kf, vf, (wave * (4 * NG) + gi * 4 + tk) * 4 + g, true, false, 0, false); } }
        __syncthreads();
        { auto process = [&](int kb, const bf16x8 (&kf)[4][2], const u32x4 (&vf)[4][2]) {
                const unsigned wsel = sm_all[lane * 8 + (kb >> 5)];
                unsigned long long mm = __ballot((wsel >> (kb & 31)) & 1u);
                while (mm != 0ull) { int tj[4]; int nt = 0;
#pragma unroll
                    for (int j = 0; j < 4; ++j) { const bool has = mm != 0ull; tj[j] = has ? (int)__builtin_ctzll(mm) : 0; nt += has ? 1 : 0; mm = has ? (mm & (mm - 1ull)) : 0ull; }
                    const int j = c >> 2; const int mytok = j == 0 ? tj[0] : j == 1 ? tj[1] : j == 2 ? tj[2] : tj[3];
                    block_step(kb, kf, vf, mytok * 4 + g, j < nt, false, 0, false); } };
            bf16x8 kfA[4][2], kfB[4][2]; u32x4 vfA[4][2], vfB[4][2];
            auto take4 = [&](unsigned long long& mm, int& rowv, bool& ok) { int tj[4]; int nt = 0;
#pragma unroll
                for (int j = 0; j < 4; ++j) { const bool has = mm != 0ull; tj[j] = has ? (int)__builtin_ctzll(mm) : 0; nt += has ? 1 : 0; mm = has ? (mm & (mm - 1ull)) : 0ull; }
                const int j = c >> 2; const int mytok = j == 0 ? tj[0] : j == 1 ? tj[1] : j == 2 ? tj[2] : tj[3]; rowv = mytok * 4 + g; ok = j < nt; };
            if (!(MODE & 64)) for (int kb = wave == 0 ? 8 : wave; kb < cur; kb += 16) {
                load_kv(kb, kfA, vfA);
                if (kb + 8 < cur) { load_kv(kb + 8, kfB, vfB);
                    unsigned long long mA = __ballot((sm_all[lane * 8 + (kb >> 5)] >> (kb & 31)) & 1u), mB = __ballot((sm_all[lane * 8 + ((kb + 8) >> 5)] >> ((kb + 8) & 31)) & 1u);
                    while (mA != 0ull && mB != 0ull) { int ra, rb; bool oa, ob; take4(mA, ra, oa); take4(mB, rb, ob);
                        block_step(kb, kfA, vfA, ra, oa, false, 0, false); block_step(kb + 8, kfB, vfB, rb, ob, false, 0, false); }
                    while (mA != 0ull) { int ra; bool oa; take4(mA, ra, oa); block_step(kb, kfA, vfA, ra, oa, false, 0, false); }
                    while (mB != 0ull) { int rb; bool ob; take4(mB, rb, ob); block_step(kb + 8, kfB, vfB, rb, ob, false, 0, false); }
                } else process(kb, kfA, vfA);
            } }
        __syncthreads();
#pragma unroll
        for (int gi = 0; gi < NG; ++gi) { const int row = (wave * (4 * NG) + gi * 4 + tk) * 4 + g; const float lt = (float)LACC[row]; const float gg = sigm(bflo((unsigned)P[(size_t)t[gi] * PW + PC_BG + hq * 3 + 1])); const float sc = lt > 0.f ? gg / lt : 0.f;
            bf16_t* O = (bf16_t*)(ws + WS_NSAO) + (size_t)t[gi] * 768 + hq * 64;
#pragma unroll
            for (int dt = 0; dt < 4; ++dt) { const u32x2 ov = *(const u32x2*)(O + dt * 16 + 4 * q); const LAS int* ip = OACC + row * 68 + dt * 16 + q; const f32x4 v = (f32x4){(float)ip[0], (float)ip[4], (float)ip[8], (float)ip[12]} * sc;
                u32x2 w; w.x = cvt_pk_bf16(bflo(ov.x) + v[0], bfhi(ov.x) + v[1]); w.y = cvt_pk_bf16(bflo(ov.y) + v[2], bfhi(ov.y) + v[3]); if ((MODE & 16) || v[0] == 12345.678f) *(u32x2*)(O + dt * 16 + 4 * q) = w; } }
        __syncthreads();
    }
    if (MODE & 8) {
        FState st[NG]; bf16x8 qw[NG][2];
#pragma unroll
        for (int gi = 0; gi < NG; ++gi) { fs_init(st[gi]);
#pragma unroll
            for (int ks = 0; ks < 2; ++ks) qw[gi][ks] = *(const bf16x8*)(P + (size_t)t[gi] * PW + PC_BQ + hq * 64 + ks * 32 + q * 8); }
        const int kb0 = (t0 - 511 > 0 ? t0 - 511 : 0) >> 6, kb1 = cur + 1;
        kv_loop(lds, P + PC_KW + kh * 64, PW, S - 1, (const bf16_t*)(ws + WS_VTW) + (size_t)kh * 64 * S, S, kb0, kb1, tid, [&](int kb, ldsp B) {
#pragma unroll
            for (int gi = 0; gi < NG; ++gi) { const int hi = t[gi] - kb * 64 - 8 * q, lo = hi - 511;
                if (kb > kb0 + 1 && kb < cur) flash_step<0>(B, ko, qw[gi], st[gi], true, [](int) { return true; });
                else flash_step<1>(B, ko, qw[gi], st[gi], true, [&](int kk) { return kk <= hi && kk >= lo; }); }
        });
#pragma unroll
        for (int gi = 0; gi < NG; ++gi) { const float lt = fs_ltot(st[gi]); const float gg = sigm(bflo((unsigned)P[(size_t)t[gi] * PW + PC_BG + hq * 3 + 2])); const float sc = lt > 0.f ? gg / lt : 0.f;
            bf16_t* O = (bf16_t*)(ws + WS_NSAO) + (size_t)t[gi] * 768 + hq * 64;
#pragma unroll
            for (int dt = 0; dt < 4; ++dt) { const u32x2 ov = *(const u32x2*)(O + dt * 16 + 4 * q); const f32x4 v = st[gi].o[dt] * sc;
                u32x2 w; w.x = cvt_pk_bf16(bflo(ov.x) + v[0], bfhi(ov.x) + v[1]); w.y = cvt_pk_bf16(bflo(ov.y) + v[2], bfhi(ov.y) + v[3]); if ((MODE & 16) || v[0] == 12345.678f) *(u32x2*)(O + dt * 16 + 4 * q) = w; } }
    }
}

__device__ __forceinline__ void dil_task(unsigned char* ws, int task, int lane) {
    const int c = lane & 15, q = lane >> 4;
    const int hh = task >> 10, u = task & 1023, gi = hh >> 2, dsh = 2 * gi  , Ls = S >> dsh, gpr = Ls >> 4  ;
    const int r = u / gpr, i0 = (u - r * gpr) * 16, ib = i0 - 128;
    bf16_t* P = (bf16_t*)(ws + WS_P);
    const int t = ((i0 + c) << dsh) + r;
    bf16x8 qf[2];
#pragma unroll
    for (int ks = 0; ks < 2; ++ks) qf[ks] = *(const bf16x8*)(P + (size_t)t * PW + PC_CQ + hh * 64 + ks * 32 + q * 8);
    f32x4 s[9];
#pragma unroll
    for (int kt = 0; kt < 9; ++kt) { int ik = ib + kt * 16 + c; ik = ik < 0 ? 0 : ik; const bf16_t* kp = P + (size_t)((ik << dsh) + r) * PW + PC_CK + hh * 64 + q * 8;
        const bf16x8 a0 = *(const bf16x8*)kp, a1 = *(const bf16x8*)(kp + 32);
        s[kt] = mfma16(a0, qf[0], (f32x4){0.f, 0.f, 0.f, 0.f}); s[kt] = mfma16(a1, qf[1], s[kt]); }
    const int base = 4 * q - 128 - c; float mx = -1e30f;
#pragma unroll
    for (int kt = 0; kt < 9; ++kt)
#pragma unroll
        for (int rr = 0; rr < 4; ++rr) { const int rel = base + kt * 16 + rr; const bool v = rel <= 0 && rel >= -128 && (ib + kt * 16 + 4 * q + rr) >= 0; s[kt][rr] = v ? s[kt][rr] : -1e30f; mx = fmaxf(mx, s[kt][rr]); }
    mx = colmax4(mx);
    float l = 0.f;
#pragma unroll
    for (int kt = 0; kt < 9; ++kt)
#pragma unroll
        for (int rr = 0; rr < 4; ++rr) { const float p = __builtin_amdgcn_exp2f(s[kt][rr] - mx); s[kt][rr] = p; l += p; }
    { float lt = l; lt += __shfl_xor(lt, 16); lt += __shfl_xor(lt, 32); l = lt; }
    const bf16_t* VT = (const bf16_t*)(ws + WS_VTC) + (size_t)hh * 64 * S + (size_t)r * Ls;
    f32x4 o[4];
#pragma unroll
    for (int dt = 0; dt < 4; ++dt) o[dt] = (f32x4){0.f, 0.f, 0.f, 0.f};
#pragma unroll
    for (int k2 = 0; k2 < 5; ++k2) {
        u32x4 pw; pw.x = cvt_pk_bf16(s[2 * k2][0], s[2 * k2][1]); pw.y = cvt_pk_bf16(s[2 * k2][2], s[2 * k2][3]);
        if (k2 < 4) { pw.z = cvt_pk_bf16(s[2 * k2 + 1][0], s[2 * k2 + 1][1]); pw.w = cvt_pk_bf16(s[2 * k2 + 1][2], s[2 * k2 + 1][3]); } else { pw.z = 0u; pw.w = 0u; }
        const bf16x8 pb = __builtin_bit_cast(bf16x8, pw);
        int c0 = ib + 32 * k2 + 4 * q; c0 = c0 < 0 ? 0 : c0; int c1 = ib + 32 * k2 + 16 + 4 * q; c1 = c1 < 0 ? 0 : c1; c1 = (k2 < 4) ? c1 : c0;
#pragma unroll
        for (int dt = 0; dt < 4; ++dt) { const bf16_t* vp = VT + (size_t)(dt * 16 + c) * S;
            const u32x2 lo = *(const u32x2*)(vp + c0), hi = *(const u32x2*)(vp + c1);
            u32x4 aw; aw.x = lo.x; aw.y = lo.y; aw.z = hi.x; aw.w = hi.y;
            o[dt] = mfma16(__builtin_bit_cast(bf16x8, aw), pb, o[dt]); } }
    const float il = 1.f / l;
    bf16_t* O = P + (size_t)t * PW + PC_AX + hh * 64;
#pragma unroll
    for (int dt = 0; dt < 4; ++dt) { const f32x4 v = o[dt] * il; u32x2 w; w.x = cvt_pk_bf16(v[0], v[1]); w.y = cvt_pk_bf16(v[2], v[3]); *(u32x2*)(O + dt * 16 + 4 * q) = w; }
    if (q == 0) ((float*)(ws + WS_LSE))[(size_t)hh * S + t] = mx + __builtin_amdgcn_logf(l);
}
__device__ __forceinline__ void dil_combine(unsigned char* ws, int tid) {
    const bf16_t* P = (const bf16_t*)(ws + WS_P); const float* LSE = (const float*)(ws + WS_LSE); bf16_t* DO = (bf16_t*)(ws + WS_DILO);
    for (int i = blockIdx.x * NT + tid; i < S * 32; i += gridDim.x * NT) { const int t = i >> 5, j = (i >> 3) & 3, ch = i & 7;
        const float l0 = LSE[(size_t)j * S + t], l1 = LSE[(size_t)(4 + j) * S + t], l2 = LSE[(size_t)(8 + j) * S + t];
        const float m = fmaxf(l0, fmaxf(l1, l2)); float w0 = __builtin_amdgcn_exp2f(l0 - m), w1 = __builtin_amdgcn_exp2f(l1 - m), w2 = __builtin_amdgcn_exp2f(l2 - m);
        const float inv = 1.f / (w0 + w1 + w2); w0 *= inv; w1 *= inv; w2 *= inv;
        const bf16_t* pr = P + (size_t)t * PW + PC_AX + j * 64 + ch * 8;
        const u32x4 a = *(const u32x4*)pr, b = *(const u32x4*)(pr + 256), cc = *(const u32x4*)(pr + 512);
        u32x4 o; o.x = cvt_pk_bf16(w0 * bflo(a.x) + w1 * bflo(b.x) + w2 * bflo(cc.x), w0 * bfhi(a.x) + w1 * bfhi(b.x) + w2 * bfhi(cc.x));
        o.y = cvt_pk_bf16(w0 * bflo(a.y) + w1 * bflo(b.y) + w2 * bflo(cc.y), w0 * bfhi(a.y) + w1 * bfhi(b.y) + w2 * bfhi(cc.y));
        o.z = cvt_pk_bf16(w0 * bflo(a.z) + w1 * bflo(b.z) + w2 * bflo(cc.z), w0 * bfhi(a.z) + w1 * bfhi(b.z) + w2 * bfhi(cc.z));
        o.w = cvt_pk_bf16(w0 * bflo(a.w) + w1 * bflo(b.w) + w2 * bflo(cc.w), w0 * bfhi(a.w) + w1 * bfhi(b.w) + w2 * bfhi(cc.w));
        *(u32x4*)(DO + (size_t)t * 256 + j * 64 + ch * 8) = o; }
}
__device__ __forceinline__ void cmp_item(unsigned char* ws, ldsp lds, int it, int tid) {
    asm volatile("" : "+v"(tid));
    const int lane = tid & 63, wave = __builtin_amdgcn_readfirstlane(tid >> 6), c = lane & 15, q = lane >> 4;
    const int kv = it / 96, rem = it % 96, h = rem / 32, c0 = (rem % 32) * 32;
    const bf16_t* P = (const bf16_t*)(ws + WS_P) + (kv ? PC_VC : PC_KC) + h * 64;
    for (int idx = tid; idx < 528 * 8; idx += NT) { const int tl = idx >> 3, ch = idx & 7; int tok = 16 * c0 + tl; tok = tok < S ? tok : S - 1;
        const u32x4 v = *(const u32x4*)(P + (size_t)tok * PW + ch * 8);
        *(LAS u32x4*)(lds + ((tl & 15) * 34 + (tl >> 4)) * 144 + ch * 16) = v; }
    __syncthreads();
    const bf16_t* W1t = (const bf16_t*)(ws + WS_WT + (kv ? WT_C1V : WT_C1K));
    f32x4 acc[2][2];
#pragma unroll
    for (int i = 0; i < 2; ++i)
#pragma unroll
        for (int j = 0; j < 2; ++j) acc[i][j] = (f32x4){0.f, 0.f, 0.f, 0.f};
    const bf16_t* wp0 = W1t + (size_t)((2 * wave) * 16 + c) * 2048 + 8 * q; const bf16_t* wp1 = wp0 + (size_t)16 * 2048;
#pragma unroll 8
    for (int ks = 0; ks < 64; ++ks) { const int l_ = ks >> 1, d0 = (ks & 1) * 32;
        const bf16x8 b0 = *(const bf16x8*)(wp0 + ks * 32), b1 = *(const bf16x8*)(wp1 + ks * 32);
        ldsp ap = lds + ((l_ & 15) * 34 + c + (l_ >> 4)) * 144 + (d0 + 8 * q) * 2;
        const bf16x8 a0 = *(const LAS bf16x8*)(ap), a1 = *(const LAS bf16x8*)(ap + 16 * 144);
        acc[0][0] = mfma16(a0, b0, acc[0][0]); acc[0][1] = mfma16(a0, b1, acc[0][1]); acc[1][0] = mfma16(a1, b0, acc[1][0]); acc[1][1] = mfma16(a1, b1, acc[1][1]); }
    LAS bf16_t* Hs = (LAS bf16_t*)(lds + 78336);
    const float* bp = (const float*)(ws + WS_BIASP) + kv * 8 * 256;
#pragma unroll
    for (int nl = 0; nl < 2; ++nl) { const int n = (2 * wave + nl) * 16 + c; float b = 0.f;
#pragma unroll
        for (int p = 0; p < 8; ++p) b += bp[p * 256 + n];
#pragma unroll
        for (int mt = 0; mt < 2; ++mt)
#pragma unroll
            for (int r = 0; r < 4; ++r) { const float v = gelu_t(acc[mt][nl][r] + b); Hs[(mt * 16 + 4 * q + r) * 264 + n] = (bf16_t)(cvt_pk_bf16(v, v) & 0xffffu); } }
    __syncthreads();
    const bf16_t* W2t = (const bf16_t*)(ws + WS_WT + (kv ? WT_C2V : WT_C2K));
    const int mt = wave >> 2, nt = wave & 3;
    f32x4 a2 = (f32x4){0.f, 0.f, 0.f, 0.f};
#pragma unroll
    for (int ks = 0; ks < 8; ++ks) { const bf16x8 av = *(const LAS bf16x8*)((ldsp)Hs + ((mt * 16 + c) * 264 + ks * 32 + 8 * q) * 2);
        const bf16x8 bv = *(const bf16x8*)(W2t + (size_t)(nt * 16 + c) * 256 + ks * 32 + 8 * q); a2 = mfma16(av, bv, a2); }
    if (kv == 0) { bf16_t* KC = (bf16_t*)(ws + WS_KC) + (size_t)h * 1024 * 64;
#pragma unroll
        for (int r = 0; r < 4; ++r) KC[(size_t)(c0 + mt * 16 + 4 * q + r) * 64 + nt * 16 + c] = (bf16_t)(cvt_pk_bf16(a2[r], a2[r]) & 0xffffu); }
    else { bf16_t* VCT = (bf16_t*)(ws + WS_VCT) + (size_t)h * 64 * 1024; u32x2 w; w.x = cvt_pk_bf16(a2[0], a2[1]); w.y = cvt_pk_bf16(a2[2], a2[3]);
        *(u32x2*)(VCT + (size_t)(nt * 16 + c) * 1024 + c0 + mt * 16 + 4 * q) = w; }
    __syncthreads();
}

__device__ __forceinline__ void lru_tile_item(unsigned char* ws, ldsp lds, int it, int l, int tid) {
    asm volatile("" : "+v"(tid));
    const int lane = tid & 63, wave = __builtin_amdgcn_readfirstlane(tid >> 6), c = lane & 15, q = lane >> 4;
    const int ci = it / 6, b = it % 6, t0 = ci * 64, ch0 = b * 128;
    const bf16_t* P = (const bf16_t*)(ws + WS_P);
    { const int tok = tid >> 3, cg = (tid & 7) * 16; float xc[16];
        const float* cb = inp(I_CONVB) + l * 768 + ch0 + cg; const float* cw = inp(I_CONVW) + (size_t)l * 4 * 768 + ch0 + cg;
#pragma unroll
        for (int i = 0; i < 16; ++i) xc[i] = cb[i];
#pragma unroll
        for (int j = 0; j < 4; ++j) { const int tt = t0 + tok - 3 + j;
            if (tt >= 0) { const u32x4 v0 = *(const u32x4*)(P + (size_t)tt * PW + PC_AX + ch0 + cg), v1 = *(const u32x4*)(P + (size_t)tt * PW + PC_AX + ch0 + cg + 8);
                const float x[16] = {bflo(v0.x), bfhi(v0.x), bflo(v0.y), bfhi(v0.y), bflo(v0.z), bfhi(v0.z), bflo(v0.w), bfhi(v0.w), bflo(v1.x), bfhi(v1.x), bflo(v1.y), bfhi(v1.y), bflo(v1.z), bfhi(v1.z), bflo(v1.w), bfhi(v1.w)};
#pragma unroll
                for (int i = 0; i < 16; ++i) xc[i] += cw[j * 768 + i] * x[i]; } }
        u32x4 w0, w1; w0.x = cvt_pk_bf16(xc[0], xc[1]); w0.y = cvt_pk_bf16(xc[2], xc[3]); w0.z = cvt_pk_bf16(xc[4], xc[5]); w0.w = cvt_pk_bf16(xc[6], xc[7]);
        w1.x = cvt_pk_bf16(xc[8], xc[9]); w1.y = cvt_pk_bf16(xc[10], xc[11]); w1.z = cvt_pk_bf16(xc[12], xc[13]); w1.w = cvt_pk_bf16(xc[14], xc[15]);
        *(LAS u32x4*)(lds + tok * 272 + cg * 2) = w0; *(LAS u32x4*)(lds + tok * 272 + cg * 2 + 16) = w1; }
    __syncthreads();
    const bf16_t* Wl = (const bf16_t*)(ws + WS_WT + WT_LRU) + (size_t)b * 256 * 128;
    f32x4 acc[2][4];
#pragma unroll
    for (int i = 0; i < 2; ++i)
#pragma unroll
        for (int j = 0; j < 4; ++j) acc[i][j] = (f32x4){0.f, 0.f, 0.f, 0.f};
#pragma unroll
    for (int ks = 0; ks < 4; ++ks) { const bf16x8 b0 = *(const bf16x8*)(Wl + (size_t)(wave * 16 + c) * 128 + ks * 32 + 8 * q), b1 = *(const bf16x8*)(Wl + (size_t)(128 + wave * 16 + c) * 128 + ks * 32 + 8 * q);
#pragma unroll
        for (int mt = 0; mt < 4; ++mt) { const bf16x8 av = *(const LAS bf16x8*)(lds + (mt * 16 + c) * 272 + (ks * 32 + 8 * q) * 2); acc[0][mt] = mfma16(av, b0, acc[0][mt]); acc[1][mt] = mfma16(av, b1, acc[1][mt]); } }
    LAS float* sa = (LAS float*)(lds + 17408); LAS float* su = (LAS float*)(lds + 17408 + 33024);
    { const int ch = wave * 16 + c; const float ba = inp(I_LRUBA)[l * 768 + ch0 + ch], bi = inp(I_LRUBI)[l * 768 + ch0 + ch]; const float sp = log1pf(__expf(-inp(I_LAM)[l * 768 + ch0 + ch]));
#pragma unroll
        for (int mt = 0; mt < 4; ++mt)
#pragma unroll
            for (int r = 0; r < 4; ++r) { const int tok = mt * 16 + 4 * q + r; const float rg = sigm(acc[0][mt][r] + ba), ig = sigm(acc[1][mt][r] + bi);
                const float la = -8.f * rg * sp; const float av = __expf(la); const float mult = sqrtf(fmaxf(1.f - av * av, 0.f));
                const float xv = bflo((unsigned)*(const LAS bf16_t*)(lds + tok * 272 + ch * 2));
                sa[tok * 129 + ch] = av; su[tok * 129 + ch] = mult * ig * xv; } }
    __syncthreads();
    if (tid < 128) { const int ch = tid; float h = 0.f, pc = 1.f;
        bf16_t* HL = (bf16_t*)(ws + WS_HLOC) + (size_t)t0 * 768 + ch0 + ch; bf16_t* CP = (bf16_t*)(ws + WS_CUMP) + (size_t)t0 * 768 + ch0 + ch;
#pragma unroll 8
        for (int t = 0; t < 64; ++t) { const float av = sa[t * 129 + ch], uv = su[t * 129 + ch]; h = av * h + uv; pc *= av;
            HL[(size_t)t * 768] = (bf16_t)(cvt_pk_bf16(h, h) & 0xffffu); CP[(size_t)t * 768] = (bf16_t)(cvt_pk_bf16(pc, pc) & 0xffffu); }
        ((float*)(ws + WS_ATOT))[ci * 768 + ch0 + ch] = pc; ((float*)(ws + WS_HEND))[ci * 768 + ch0 + ch] = h; }
    __syncthreads();
}
__device__ __forceinline__ void lru_apply_item(unsigned char* ws, ldsp lds, int it, int tid) {
    asm volatile("" : "+v"(tid));
    const int g16 = it / 6, b = it % 6, ch0 = b * 128, c0 = g16 * 16;
    LAS float* sA = (LAS float*)lds; LAS float* sH = sA + 512; LAS float* sC = sH + 512;
    const float* at = (const float*)(ws + WS_ATOT) + ch0; const float* he = (const float*)(ws + WS_HEND) + ch0;
    { const int ch = tid & 127, part = tid >> 7; const int j0 = part * c0 / 4, j1 = (part + 1) * c0 / 4; float A = 1.f, H = 0.f;
#pragma unroll 16
        for (int j = j0; j < j1; ++j) { const float av = at[(size_t)j * 768 + ch], hv = he[(size_t)j * 768 + ch]; H = av * H + hv; A *= av; }
        sA[part * 128 + ch] = A; sH[part * 128 + ch] = H; }
    __syncthreads();
    if (tid < 128) { float cr = 0.f;
#pragma unroll
        for (int p = 0; p < 4; ++p) cr = sA[p * 128 + tid] * cr + sH[p * 128 + tid];
        sC[tid] = cr; }
    __syncthreads();
#pragma unroll 1
    for (int k = 0; k < 16; ++k) { const int ci = c0 + k, t0 = ci * 64;
        float na = 0.f, nh = 0.f; if (tid < 128) { na = at[(size_t)ci * 768 + tid]; nh = he[(size_t)ci * 768 + tid]; }
        { const int tok = tid >> 3, cg = (tid & 7) * 16; const size_t ro = (size_t)(t0 + tok) * 768 + ch0 + cg;
            const bf16_t* HL = (const bf16_t*)(ws + WS_HLOC) + ro; const bf16_t* CP = (const bf16_t*)(ws + WS_CUMP) + ro; const bf16_t* G = (const bf16_t*)(ws + WS_P) + (size_t)(t0 + tok) * PW + PC_AG + ch0 + cg;
            bf16_t* Y = (bf16_t*)(ws + WS_YA) + ro;
#pragma unroll
            for (int hf = 0; hf < 2; ++hf) { const u32x4 hv = *(const u32x4*)(HL + 8 * hf), cv = *(const u32x4*)(CP + 8 * hf), gv = *(const u32x4*)(G + 8 * hf); const LAS float* cc = sC + cg + 8 * hf;
                u32x4 w; w.x = cvt_pk_bf16((bflo(hv.x) + bflo(cv.x) * cc[0]) * bflo(gv.x), (bfhi(hv.x) + bfhi(cv.x) * cc[1]) * bfhi(gv.x));
                w.y = cvt_pk_bf16((bflo(hv.y) + bflo(cv.y) * cc[2]) * bflo(gv.y), (bfhi(hv.y) + bfhi(cv.y) * cc[3]) * bfhi(gv.y));
                w.z = cvt_pk_bf16((bflo(hv.z) + bflo(cv.z) * cc[4]) * bflo(gv.z), (bfhi(hv.z) + bfhi(cv.z) * cc[5]) * bfhi(gv.z));
                w.w = cvt_pk_bf16((bflo(hv.w) + bflo(cv.w) * cc[6]) * bflo(gv.w), (bfhi(hv.w) + bfhi(cv.w) * cc[7]) * bfhi(gv.w));
                *(u32x4*)(Y + 8 * hf) = w; } }
        __syncthreads();
        if (tid < 128) sC[tid] = na * sC[tid] + nh;
        __syncthreads(); }
}
__device__ __forceinline__ void vt_item(unsigned char* ws, ldsp lds, int tt, int tid) {
    asm volatile("" : "+v"(tid));
    const int lane = tid & 63, wave = __builtin_amdgcn_readfirstlane(tid >> 6);
    const bf16_t* P = (const bf16_t*)(ws + WS_P);
#pragma unroll 1
    for (int grp = 0; grp < 3; ++grp) {
        { const int tok = tid >> 3, ch = tid & 7;
#pragma unroll
            for (int s6 = 0; s6 < 6; ++s6) { const int s = grp * 6 + s6; const int sc = s < 3 ? PC_VS + s * 64 : s < 6 ? PC_VW + (s - 3) * 64 : PC_CV + (s - 6) * 64;
                const u32x4 v = *(const u32x4*)(P + (size_t)(tt * 64 + tok) * PW + sc + ch * 8); *(LAS u32x4*)(lds + tok * 784 + (s6 * 64 + ch * 8) * 2) = v; } }
        __syncthreads();
#pragma unroll
        for (int s6 = 0; s6 < 6; ++s6) { const int s = grp * 6 + s6; unsigned short e[8];
            const int dsel = s < 10 ? 0 : s < 14 ? 1 : 2;
#pragma unroll
            for (int i = 0; i < 8; ++i) { const int tok = dsel == 0 ? wave * 8 + i : dsel == 1 ? (wave & 3) + 4 * (8 * (wave >> 2) + i) : 2 * wave + (i >> 2) + 16 * (i & 3);
                e[i] = *(const LAS unsigned short*)(lds + tok * 784 + (s6 * 64 + lane) * 2); }
            u32x4 w; w.x = e[0] | ((unsigned)e[1] << 16); w.y = e[2] | ((unsigned)e[3] << 16); w.z = e[4] | ((unsigned)e[5] << 16); w.w = e[6] | ((unsigned)e[7] << 16);
            const size_t dofs = s < 3 ? WS_VTS + (size_t)(s * 64 + lane) * S * 2 : s < 6 ? WS_VTW + (size_t)((s - 3) * 64 + lane) * S * 2 : WS_VTC + (size_t)((s - 6) * 64 + lane) * S * 2; bf16_t* dst = (bf16_t*)(ws + dofs);
            if (dsel == 0) *(u32x4*)(dst + tt * 64 + wave * 8) = w;
            else if (dsel == 1) *(u32x4*)(dst + (wave & 3) * (S / 4) + tt * 16 + 8 * (wave >> 2)) = w;
            else { u32x2 w0, w1; w0.x = w.x; w0.y = w.y; w1.x = w.z; w1.y = w.w; *(u32x2*)(dst + (2 * wave) * (S / 16) + tt * 4) = w0; *(u32x2*)(dst + (2 * wave + 1) * (S / 16) + tt * 4) = w1; } }
        __syncthreads();
    }
}

#define ssql ((float*)(wsl + WS_SSQ))
#define Xl ((float*)inp(29))
#define XBl ((bf16_t*)(wsl + WS_XB))
#define ctrl ((unsigned*)(wsl + WS_CTR))
#define wt (wsl + WS_WT)
#define P ((bf16_t*)(wsl + WS_P))
#define HID ((bf16_t*)(wsl + WS_HID))
#define MG ((bf16_t*)(wsl + WS_MERGED))
#define XBAR() do { XcdBarrier xb_; xb_.bar = (unsigned*)(wsl + WS_BAR); xb_.x = xb_xcc_id(); xb_.st = (volatile LAS unsigned*)(lds + LDS_BYTES - 32); xcd_barrier(xb_); } while (0)
#ifndef PH
#define PH 0xFFFF
#endif
__device__ __forceinline__ int next_item(unsigned* ctr, LAS int* slot, int tid) {
    __syncthreads(); if (tid == 0) *slot = (int)atomicAdd(ctr, 1u); __syncthreads(); return *slot;
}
template <class Epi>
__device__ __forceinline__ void run_gemm(ldsp lds, const bf16_t* A, const bf16_t* Bt, int N, int K, const Epi& E) {
    pg8::Gemm g{A, Bt, S, N, K}; pg8::StaticOrder So; So.init(S, N, (int)gridDim.x, (int)blockIdx.x);
    pg8::gemm_phase<Epi, pg8::StaticOrder, true, true>(lds, g, So, E);
}

__global__ void __launch_bounds__(NT, 2) mega(Args a) {
    extern __shared__ __attribute__((aligned(16))) unsigned char lds_raw[];
    ldsp lds = (ldsp)lds_raw;
    LAS int* slot = (LAS int*)(lds + LDS_BYTES - 64);
    cg::grid_group grid = cg::this_grid();
    const int tid = threadIdx.x, lane = tid & 63, wave = tid >> 6;
    const int gw = blockIdx.x * 8 + wave, NGW = gridDim.x * 8;
    unsigned char* ws = (unsigned char*)inp(30);
    float* ssq = (float*)(ws + WS_SSQ); unsigned* ctr = (unsigned*)(ws + WS_CTR);
    float* X = (float*)inp(29); bf16_t* XB = (bf16_t*)(ws + WS_XB);
    for (int m = gw; m < S; m += NGW) {
        const float4* xr = (const float4*)(inp(I_X) + (size_t)m * DM) + lane; float4* orow = (float4*)(X + (size_t)m * DM) + lane; u32x2* xb = (u32x2*)(XB + (size_t)m * DM) + lane;
        float s = 0.f;
#pragma unroll
        for (int j = 0; j < 4; ++j) { const float4 v = xr[64 * j]; s += v.x * v.x + v.y * v.y + v.z * v.z + v.w * v.w; orow[64 * j] = v; u32x2 w; w.x = cvt_pk_bf16(v.x, v.y); w.y = cvt_pk_bf16(v.z, v.w); xb[64 * j] = w; }
        s = wave_sum(s);
        if (lane < 16) ssq[(size_t)m * 16 + lane] = lane == 0 ? s : 0.f;
    }
    if (blockIdx.x == 0 && tid < 64) ctr[tid] = 0u;
    if (blockIdx.x == 0) for (int i = tid; i < XCD_BAR_WORDS; i += NT) ((unsigned*)(ws + WS_BAR))[i] = 0u;
    volatile LAS unsigned* bst = (volatile LAS unsigned*)(lds + LDS_BYTES - 32); if (tid < 2) bst[tid] = 0u;
    prep_phase(ws, 0, 0, lds, tid); prep_phase(ws, 0, 1, lds, tid);
    grid.sync();
    (void)xcd_barrier_post((unsigned*)(ws + WS_BAR), bst);
#pragma unroll 1
    for (int l = 0; l < NL; ++l) {
        int tl = threadIdx.x; asm volatile("" : "+v"(tl));
        unsigned long long wsb = (unsigned long long)ws; asm volatile("" : "+s"(wsb)); unsigned char* wsl = (unsigned char*)(__attribute__((address_space(1))) unsigned char*)wsb;
#if PH & 1
        run_gemm(lds, XBl, (const bf16_t*)(wt + WT_W13A), 5632, 1024, pg8::EpiSwiGLU{HID, ssql});
#endif
#if defined(DUP_X) && (DUP_X & 4)
        XBAR(); run_gemm(lds, XBl, (const bf16_t*)(wt + WT_W13A), 5632, 1024, pg8::EpiSwiGLU{HID, ssql});
#endif
        XBAR(); asm volatile("" : "+s"(wsb)); wsl = (unsigned char*)(__attribute__((address_space(1))) unsigned char*)wsb;
#if PH & 2
        run_gemm(lds, HID, (const bf16_t*)(wt + WT_W2A), 1024, 2816, pg8::EpiResid{Xl, XBl, ssql, 0.5f});
#endif
        XBAR(); asm volatile("" : "+s"(wsb)); wsl = (unsigned char*)(__attribute__((address_space(1))) unsigned char*)wsb;
#if PH & 4
        run_gemm(lds, XBl, (const bf16_t*)(wt + WT_WIN), PW, 1024, pg8::EpiProj{P, ssql});
#endif
#if defined(DUP_X) && (DUP_X & 8)
        XBAR(); run_gemm(lds, XBl, (const bf16_t*)(wt + WT_WIN), PW, 1024, pg8::EpiProj{P, ssql});
#endif
        XBAR(); asm volatile("" : "+s"(wsb)); wsl = (unsigned char*)(__attribute__((address_space(1))) unsigned char*)wsb;
#if PH & 8
        for (;;) { const int it = next_item(ctrl + 2 * l, slot, tl); if (it >= 1984 + PREP_GC_B) break;
            if (it < 192) cmp_item(wsl, lds, it, tl); else if (it < 448) vt_item(wsl, lds, it - 192, tl); else if (it < 1984) lru_tile_item(wsl, lds, it - 448, l, tl); else prep_block_item(wsl, l, 2, it - 1984, lds, tl); }
#endif
#if defined(DUP_X) && (DUP_X & 2)
        XBAR();
        for (;;) { const int it = next_item(ctrl + 24 + l, slot, tl); if (it >= 192 + 256 + 1536) break;
            if (it < 192) cmp_item(wsl, lds, it, tl); else if (it < 448) vt_item(wsl, lds, it - 192, tl); else lru_tile_item(wsl, lds, it - 448, l, tl); }
#endif
        XBAR(); asm volatile("" : "+s"(wsb)); wsl = (unsigned char*)(__attribute__((address_space(1))) unsigned char*)wsb;
#if PH & 16
        { const int nprep = (l + 1 < NL) ? PREP_GA_B + PREP_GB_B : 0;
        for (;;) { const int it = next_item(ctrl + 2 * l + 1, slot, tl); if (it >= 2400 + nprep) break;
            if (it < 96) lru_apply_item(wsl, lds, it, tl); else if (it < 864) { const int ni = it - 96; nsa_item<31>(wsl, lds, 255 - (ni & 255), ni >> 8, tl); } else if (it < 2400) dil_task(wsl, (it - 864) * 8 + (tl >> 6), tl & 63);
            else if (it < 2400 + PREP_GA_B) prep_block_item(wsl, l + 1, 0, it - 2400, lds, tl); else prep_block_item(wsl, l + 1, 1, it - 2400 - PREP_GA_B, lds, tl); } }
#endif
#ifdef DUP_NSA
        XBAR(); asm volatile("" : "+s"(wsb)); wsl = (unsigned char*)(__attribute__((address_space(1))) unsigned char*)wsb;
        for (;;) { const int it = next_item(ctrl + 16 + l, slot, tl); if (it >= 768) break; nsa_item<DUP_NSA>(wsl, lds, 255 - (it & 255), it >> 8, tl); }
#endif
#ifdef DUP_M2ALL
        XBAR(); asm volatile("" : "+s"(wsb)); wsl = (unsigned char*)(__attribute__((address_space(1))) unsigned char*)wsb;
        { const int nprep = (l + 1 < NL) ? PREP_GA_B + PREP_GB_B : 0;
        for (;;) { const int it = next_item(ctrl + 16 + l, slot, tl); if (it >= 2400 + nprep) break;
            if (it < 96) lru_apply_item(wsl, lds, it, tl); else if (it < 864) { const int ni = it - 96; nsa_item<31>(wsl, lds, 255 - (ni & 255), ni >> 8, tl); } else if (it < 2400) dil_task(wsl, (it - 864) * 8 + (tl >> 6), tl & 63);
            else if (it < 2400 + PREP_GA_B) prep_block_item(wsl, l + 1, 0, it - 2400, lds, tl); else prep_block_item(wsl, l + 1, 1, it - 2400 - PREP_GA_B, lds, tl); } }
#endif
        XBAR(); asm volatile("" : "+s"(wsb)); wsl = (unsigned char*)(__attribute__((address_space(1))) unsigned char*)wsb;
        dil_combine(wsl, tl);
        XBAR(); asm volatile("" : "+s"(wsb)); wsl = (unsigned char*)(__attribute__((address_space(1))) unsigned char*)wsb;
#if PH & 32
        run_gemm(lds, (const bf16_t*)(wsl + WS_YA), (const bf16_t*)(wt + WT_UA), 1024, 768, pg8::EpiMerge<0>{MG, P + PC_MA});
        run_gemm(lds, (const bf16_t*)(wsl + WS_NSAO), (const bf16_t*)(wt + WT_UB), 1024, 768, pg8::EpiMerge<1>{MG, P + PC_MB});
        run_gemm(lds, (const bf16_t*)(wsl + WS_DILO), (const bf16_t*)(wt + WT_UC), 1024, 256, pg8::EpiMerge<1>{MG, P + PC_MC});
#endif
        XBAR(); asm volatile("" : "+s"(wsb)); wsl = (unsigned char*)(__attribute__((address_space(1))) unsigned char*)wsb;
#if PH & 64
        run_gemm(lds, MG, (const bf16_t*)(wt + WT_WO), 1024, 1024, pg8::EpiResid{Xl, XBl, ssql, 1.0f});
#endif
        XBAR(); asm volatile("" : "+s"(wsb)); wsl = (unsigned char*)(__attribute__((address_space(1))) unsigned char*)wsb;
#if defined(DUP_X) && (DUP_X & 16)
        for (int k = 0; k < 8; ++k) XBAR();
#endif
#if PH & 128
        run_gemm(lds, XBl, (const bf16_t*)(wt + WT_W13B), 5632, 1024, pg8::EpiSwiGLU{HID, ssql});
#endif
        XBAR(); asm volatile("" : "+s"(wsb)); wsl = (unsigned char*)(__attribute__((address_space(1))) unsigned char*)wsb;
#if PH & 256
        run_gemm(lds, HID, (const bf16_t*)(wt + WT_W2B), 1024, 2816, pg8::EpiResid{Xl, XBl, ssql, 0.5f});
#endif
        XBAR(); asm volatile("" : "+s"(wsb)); wsl = (unsigned char*)(__attribute__((address_space(1))) unsigned char*)wsb;
    }
    int tf = threadIdx.x; asm volatile("" : "+v"(tf));
    unsigned char* wsf = (unsigned char*)inp(30); float* Xf = (float*)inp(29);
    const int lanef = tf & 63; const int gwf = blockIdx.x * 8 + (tf >> 6);
    for (int m = gwf; m < S; m += NGW) {
        float4* orow = (float4*)(Xf + (size_t)m * DM) + lanef; const float4* g = (const float4*)(inp(I_FINN)) + lanef;
        const float r = rsqrtf(pg8::rsum16((const float*)(wsf + WS_SSQ), m) * (1.f / DM) + 1e-6f);
#pragma unroll
        for (int j = 0; j < 4; ++j) { float4 v = orow[64 * j]; const float4 gg = g[64 * j]; v.x *= r * gg.x; v.y *= r * gg.y; v.z *= r * gg.z; v.w *= r * gg.w; orow[64 * j] = v; }
    }
}

#undef ssql
#undef Xl
#undef XBl
#undef ctrl
#undef wt
#undef P
#undef HID
#undef MG
extern "C" void kernel_launch(void* const* d_in, const int* in_sizes, int n_in, void* d_out, int out_size, void* d_ws, size_t ws_size, hipStream_t stream) {
    static int grid_blocks = 0;
    if (!grid_blocks) {
        int dev = 0, cus = 0, per_cu = 0;
        (void)hipGetDevice(&dev);
        (void)hipDeviceGetAttribute(&cus, hipDeviceAttributeMultiprocessorCount, dev);
        (void)hipFuncSetAttribute((const void*)mega, hipFuncAttributeMaxDynamicSharedMemorySize, LDS_BYTES);
        (void)hipOccupancyMaxActiveBlocksPerMultiprocessor(&per_cu, (const void*)mega, NT, LDS_BYTES);
        if (per_cu < 1) per_cu = 1;
        grid_blocks = cus * per_cu;
        if (ws_size < WS_END) { fprintf(stderr, "kernel_launch: workspace too small: %zu < %zu\n", ws_size, (size_t)WS_END); grid_blocks = -1; }
    }
    if (grid_blocks < 0) return;
    Args a{};
    for (int i = 0; i < 29; ++i) a.in[i] = (const float*)d_in[i];
    a.out = (float*)d_out; a.ws = (unsigned char*)d_ws;
    void* args[] = {&a};
    hipError_t e = hipLaunchCooperativeKernel((const void*)mega, dim3(grid_blocks), dim3(NT), args, LDS_BYTES, stream);
    if (e != hipSuccess) fprintf(stderr, "cooperative launch failed: %s (grid %d)\n", hipGetErrorString(e), grid_blocks);
}
```

```cpp
#include <hip/hip_runtime.h>
#include <hip/hip_cooperative_groups.h>
#include <cstdio>
#include <cstdint>
namespace cg = cooperative_groups;
namespace pg8 {
#define PG8_LAS __attribute__((address_space(3)))
typedef unsigned short bf16_t;
typedef short bf16x8 __attribute__((ext_vector_type(8)));
typedef float f32x4 __attribute__((ext_vector_type(4)));
typedef unsigned u32x4 __attribute__((ext_vector_type(4)));
constexpr int BM = 256, BK = 64, HALF = 128, HTB = HALF * BK * 2  , STAGE_BYTES = 8 * HTB, NXCD = 8, WGM = 8;

__host__ __device__ __forceinline__ int lds_byte(int r, int c) { const int st = (r >> 4) * 2 + (c >> 5), rr = r & 15, cc = c & 31, ob = rr * 64 + cc * 2; return st * 1024 + (ob ^ (((ob >> 9) & 1) << 5)); }
__host__ __device__ __forceinline__ void stage_rc(int b, int& R, int& C) { const int st = b / 1024, sb = b % 1024, swz = sb ^ (((sb >> 9) & 1) << 5); R = (st >> 1) * 16 + swz / 64; C = (st & 1) * 32 + (swz % 64) / 2; }
__host__ __device__ __forceinline__ int perm32(int rho) { const int n = rho >> 4, i = rho & 15; return 8 * (i >> 2) + 4 * n + (i & 3); }

struct Unit { int pm, pn; };
struct Gemm { const bf16_t* A; const bf16_t* Bt; int M, N, K; };

struct StaticOrder {
    int nM, nN, nwg, G, c;
    __host__ __device__ void init(int M, int N, int G_, int c_) { nM = M / BM; nN = N / BM; nwg = nM * nN; G = G_; c = c_; }
    __host__ __device__ bool next(int i, Unit& u) const {
        const long L = (long)i * G + c; if (L >= nwg) return false;
        int wgid = (int)L; { const int q = nwg / NXCD, r = nwg % NXCD, xcd = wgid % NXCD, off = wgid / NXCD; wgid = (xcd < r ? xcd * (q + 1) : r * (q + 1) + (xcd - r) * q) + off; }
        const int nig = WGM * nN, gid = wgid / nig, fm = gid * WGM, gsz = (nM - fm) < WGM ? (nM - fm) : WGM;
        u.pm = fm + ((wgid % nig) % gsz); u.pn = (wgid % nig) / gsz; return true;
    }
    __device__ __forceinline__ void a_ready(const Unit&) const {}
    __device__ __forceinline__ void done(const Unit&) const {}
};

typedef unsigned u32x2 __attribute__((ext_vector_type(2)));
typedef float f32x2_t __attribute__((ext_vector_type(2))); typedef __bf16 bf16x2_t __attribute__((ext_vector_type(2)));
__device__ __forceinline__ unsigned cvt_pk_bf16(float lo, float hi) { const f32x2_t v = {lo, hi}; const bf16x2_t b = __builtin_convertvector(v, bf16x2_t); return __builtin_bit_cast(unsigned, b); }
__device__ __forceinline__ float bflo(unsigned u) { return __uint_as_float(u << 16); }
__device__ __forceinline__ float bfhi(unsigned u) { return __uint_as_float(u & 0xffff0000u); }
__device__ __forceinline__ float sigm(float v) { return __builtin_amdgcn_rcpf(1.f + __expf(-v)); }
__device__ __forceinline__ float gelu_t(float v) { const float u = 1.5957691216f * (v + 0.044715f * v * v * v); return v * sigm(u); }

constexpr int DM = 1024, DFF = 2816, PW = 8960;
constexpr float RMS_EPS = 1e-6f;
__device__ __forceinline__ float rsum16(const float* ssq, int row) { const f32x4* p = (const f32x4*)(ssq + (size_t)row * 16); const f32x4 a = p[0], b = p[1], c = p[2], d = p[3];
    return (((a[0] + a[1]) + (a[2] + a[3])) + ((b[0] + b[1]) + (b[2] + b[3]))) + (((c[0] + c[1]) + (c[2] + c[3])) + ((d[0] + d[1]) + (d[2] + d[3]))); }
constexpr int PC_AX = 0, PC_AG = 768, PC_BQ = 1536, PC_CQ = 2304, PC_CK = 3072, PC_CV = 3840, PC_MA = 4608, PC_MB = 5632, PC_MC = 6656,
              PC_KC = 7680, PC_VC = 7872, PC_KS = 8064, PC_VS = 8256, PC_KW = 8448, PC_VW = 8640, PC_BG = 8832;
constexpr float QSCALE = 0.125f * 1.4426950408889634f;

struct EpiSwiGLU {
    static constexpr bool PERM = true, AFTER_DRAIN = false;
    bf16_t* H; const float* ssq;
    __device__ __forceinline__ void operator()(const f32x4 (&acc)[2][2][4][2], const Unit& u, int wr, int wc, int fr, int fq) const {
        const int row0 = u.pm * BM + wr * 64 + fr; const int hc0 = u.pn * 128 + wc * 16 + 4 * fq;
#pragma unroll
        for (int ai = 0; ai < 2; ++ai)
#pragma unroll
            for (int m = 0; m < 4; ++m) { const int row = row0 + ai * HALF + m * 16; const float rs = rsqrtf(rsum16(ssq, row) * (1.f / DM) + RMS_EPS);
#pragma unroll
                for (int bj = 0; bj < 2; ++bj) { const f32x4 a = acc[ai][bj][m][0] * rs, b = acc[ai][bj][m][1] * rs; float h[4];
#pragma unroll
                    for (int i = 0; i < 4; ++i) h[i] = a[i] * sigm(a[i]) * b[i];
                    u32x2 w; w.x = cvt_pk_bf16(h[0], h[1]); w.y = cvt_pk_bf16(h[2], h[3]);
                    *(u32x2*)(H + (size_t)row * DFF + hc0 + bj * 64) = w; } }
    }
};
struct EpiResid {
    static constexpr bool PERM = false, AFTER_DRAIN = false;
    float* X; bf16_t* XB; float* ssq_out; float scale;
    __device__ __forceinline__ void operator()(const f32x4 (&acc)[2][2][4][2], const Unit& u, int wr, int wc, int fr, int fq) const {
        const int row0 = u.pm * BM + wr * 64 + fr; const int col0 = u.pn * BM + wc * 32 + 4 * fq;
#pragma unroll
        for (int ai = 0; ai < 2; ++ai)
#pragma unroll
            for (int m = 0; m < 4; ++m) { const int row = row0 + ai * HALF + m * 16; float ss = 0.f;
#pragma unroll
                for (int bj = 0; bj < 2; ++bj)
#pragma unroll
                    for (int n = 0; n < 2; ++n) { const size_t off = (size_t)row * DM + col0 + bj * HALF + n * 16;
                        f32x4 xv = *(const f32x4*)(X + off); xv = xv + acc[ai][bj][m][n] * scale; *(f32x4*)(X + off) = xv;
                        u32x2 w; w.x = cvt_pk_bf16(xv[0], xv[1]); w.y = cvt_pk_bf16(xv[2], xv[3]); *(u32x2*)(XB + off) = w;
                        ss += (xv[0] * xv[0] + xv[1] * xv[1]) + (xv[2] * xv[2] + xv[3] * xv[3]); }
                ss += __shfl_xor(ss, 16); ss += __shfl_xor(ss, 32);
                if (fq == 0) ssq_out[(size_t)row * 16 + u.pn * 4 + wc] = ss; }
    }
};
struct EpiProj {
    static constexpr bool PERM = true, AFTER_DRAIN = false;
    bf16_t* P; const float* ssq;
    __device__ __forceinline__ void operator()(const f32x4 (&acc)[2][2][4][2], const Unit& u, int wr, int wc, int fr, int fq) const {
        const int row0 = u.pm * BM + wr * 64 + fr; const int col0 = u.pn * BM + wc * 32 + 8 * fq;
        const int pn = u.pn; const int act = (pn >= 3 && pn < 6) ? 1 : (pn >= 6 && pn < 12) ? 2 : (pn >= 18 && pn < 30) ? 3 : 0;
#pragma unroll
        for (int ai = 0; ai < 2; ++ai)
#pragma unroll
            for (int m = 0; m < 4; ++m) { const int row = row0 + ai * HALF + m * 16; float rs = rsqrtf(rsum16(ssq, row) * (1.f / DM) + RMS_EPS); if (act == 2) rs *= QSCALE;
#pragma unroll
                for (int bj = 0; bj < 2; ++bj) { f32x4 v0 = acc[ai][bj][m][0] * rs, v1 = acc[ai][bj][m][1] * rs;
                    if (act == 1) {
#pragma unroll
                        for (int i = 0; i < 4; ++i) { v0[i] = gelu_t(v0[i]); v1[i] = gelu_t(v1[i]); } }
                    else if (act == 3) {
#pragma unroll
                        for (int i = 0; i < 4; ++i) { v0[i] = sigm(v0[i]); v1[i] = sigm(v1[i]); } }
                    u32x4 w; w.x = cvt_pk_bf16(v0[0], v0[1]); w.y = cvt_pk_bf16(v0[2], v0[3]); w.z = cvt_pk_bf16(v1[0], v1[1]); w.w = cvt_pk_bf16(v1[2], v1[3]);
                    *(u32x4*)(P + (size_t)row * PW + col0 + bj * HALF) = w; } }
    }
};
template <int ACCUM> struct EpiMerge {
    static constexpr bool PERM = true, AFTER_DRAIN = false;
    bf16_t* Mg; const bf16_t* G;
    __device__ __forceinline__ void operator()(const f32x4 (&acc)[2][2][4][2], const Unit& u, int wr, int wc, int fr, int fq) const {
        const int row0 = u.pm * BM + wr * 64 + fr; const int col0 = u.pn * BM + wc * 32 + 8 * fq;
#pragma unroll
        for (int ai = 0; ai < 2; ++ai)
#pragma unroll
            for (int m = 0; m < 4; ++m) { const int row = row0 + ai * HALF + m * 16;
#pragma unroll
                for (int bj = 0; bj < 2; ++bj) { const u32x4 g = *(const u32x4*)(G + (size_t)row * PW + col0 + bj * HALF);
                    const f32x4 a0 = acc[ai][bj][m][0], a1 = acc[ai][bj][m][1];
                    float v[8] = {bflo(g.x) * a0[0], bfhi(g.x) * a0[1], bflo(g.y) * a0[2], bfhi(g.y) * a0[3], bflo(g.z) * a1[0], bfhi(g.z) * a1[1], bflo(g.w) * a1[2], bfhi(g.w) * a1[3]};
                    bf16_t* mp = Mg + (size_t)row * DM + col0 + bj * HALF;
                    if (ACCUM) { const u32x4 o = *(const u32x4*)mp; v[0] += bflo(o.x); v[1] += bfhi(o.x); v[2] += bflo(o.y); v[3] += bfhi(o.y); v[4] += bflo(o.z); v[5] += bfhi(o.z); v[6] += bflo(o.w); v[7] += bfhi(o.w); }
                    u32x4 w; w.x = cvt_pk_bf16(v[0], v[1]); w.y = cvt_pk_bf16(v[2], v[3]); w.z = cvt_pk_bf16(v[4], v[5]); w.w = cvt_pk_bf16(v[6], v[7]);
                    *(u32x4*)mp = w; } }
    }
};

template <class Epi, class Sched, bool ALIGN_EPI = false, bool SP2 = false>
__device__ __forceinline__ void gemm_phase(PG8_LAS unsigned char* lds, const Gemm g, const Sched& S, const Epi& E) {
    int tid = threadIdx.x; asm volatile("" : "+v"(tid));
    const int wid = __builtin_amdgcn_readfirstlane(tid >> 6), lane = tid & 63, wr = wid >> 2, wc = wid & 3, fr = lane & 15, fq = lane >> 4;
    const int K = g.K, nt = K / BK;
    unsigned voffA[2], voffB[2];
#pragma unroll
    for (int i = 0; i < 2; ++i) { int R, C; stage_rc(tid * 16 + i * 8192, R, C); const int Rb = Epi::PERM ? ((R & ~31) + perm32(R & 31)) : R;
        voffA[i] = (unsigned)(R * K + C) * 2u; voffB[i] = (unsigned)(Rb * K + C) * 2u; }
    const size_t kstep = (size_t)(BK * 2);
    const size_t hstep = (size_t)HALF * K * 2;
    const size_t tstep = 2 * hstep;
    const unsigned ldsw = (unsigned)wid * 1024u;
    const int aoff = lds_byte(wr * 64 + fr, fq * 8), boff = lds_byte(wc * 32 + fr, fq * 8);
#define PG8_SA(b, h) (((b) * 2 + (h)) * HTB)
#define PG8_SB(b, h) ((4 + (b) * 2 + (h)) * HTB)
#define PG8_STAGE(bufoff, gbase, voff) do { _Pragma("unroll") for (int _i = 0; _i < 2; ++_i) \
        __builtin_amdgcn_global_load_lds((const unsigned*)((const char*)(gbase) + (voff)[_i]), (PG8_LAS unsigned*)(lds + (bufoff) + ldsw + _i * 8192), 16, 0, 0); } while (0)
#define PG8_LDA(dst, b, h) do { _Pragma("unroll") for (int m = 0; m < 4; ++m) _Pragma("unroll") for (int k = 0; k < 2; ++k) dst[m][k] = *(const PG8_LAS bf16x8*)(lds + PG8_SA(b, h) + aoff + m * 2048 + k * 1024); } while (0)
#define PG8_LDB(dst, b, h) do { _Pragma("unroll") for (int n = 0; n < 2; ++n) _Pragma("unroll") for (int k = 0; k < 2; ++k) dst[n][k] = *(const PG8_LAS bf16x8*)(lds + PG8_SB(b, h) + boff + n * 2048 + k * 1024); } while (0)
#define PG8_MMA(ai, bj, At, Bt) do { __builtin_amdgcn_s_setprio(1); _Pragma("unroll") for (int m = 0; m < 4; ++m) _Pragma("unroll") for (int n = 0; n < 2; ++n) _Pragma("unroll") for (int k = 0; k < 2; ++k) \
        acc[ai][bj][m][n] = __builtin_amdgcn_mfma_f32_16x16x32_bf16(Bt[n][k], At[m][k], acc[ai][bj][m][n], 0, 0, 0); __builtin_amdgcn_s_setprio(0); } while (0)
#define PG8_WAIT_V(n) asm volatile("s_waitcnt vmcnt(" #n ")" ::: "memory")
#define PG8_WAIT_L(n) asm volatile("s_waitcnt lgkmcnt(" #n ")" ::: "memory")
#define PG8_BAR __builtin_amdgcn_s_barrier()
#define PG8_SCHED __builtin_amdgcn_sched_barrier(0)
    Unit cur, nxt; int ui = 0;
    if (!S.next(0, cur)) return;
    f32x4 acc[2][2][4][2];
#pragma unroll
    for (int a = 0; a < 2; ++a)
#pragma unroll
        for (int b = 0; b < 2; ++b)
#pragma unroll
            for (int m = 0; m < 4; ++m)
#pragma unroll
                for (int n = 0; n < 2; ++n) acc[a][b][m][n] = (f32x4){0.f, 0.f, 0.f, 0.f};
    bf16x8 At[4][2], B0[2][2], B1[2][2];
    const char* cA = (const char*)g.A + (size_t)cur.pm * tstep; const char* cB = (const char*)g.Bt + (size_t)cur.pn * tstep;
    S.a_ready(cur);
    if constexpr (SP2) {
        PG8_STAGE(PG8_SB(0, 0), cB, voffB); PG8_STAGE(PG8_SB(0, 1), cB + hstep, voffB); PG8_STAGE(PG8_SA(0, 0), cA, voffA); PG8_STAGE(PG8_SA(0, 1), cA + hstep, voffA);
        if (wr == 1) PG8_BAR;
        PG8_WAIT_V(2); PG8_BAR;
        PG8_STAGE(PG8_SB(1, 0), cB + kstep, voffB); PG8_STAGE(PG8_SA(1, 0), cA + kstep, voffA); PG8_STAGE(PG8_SB(1, 1), cB + hstep + kstep, voffB);
        PG8_WAIT_V(6); PG8_BAR;
    } else {
        PG8_STAGE(PG8_SB(0, 0), cB, voffB); PG8_STAGE(PG8_SA(0, 0), cA, voffA); PG8_STAGE(PG8_SB(0, 1), cB + hstep, voffB); PG8_STAGE(PG8_SA(0, 1), cA + hstep, voffA);
        if (wr == 1) PG8_BAR;
        PG8_WAIT_V(4); PG8_BAR;
        PG8_STAGE(PG8_SB(1, 0), cB + kstep, voffB); PG8_STAGE(PG8_SA(1, 0), cA + kstep, voffA); PG8_STAGE(PG8_SB(1, 1), cB + hstep + kstep, voffB);
        PG8_WAIT_V(6); PG8_BAR;
    }
    for (;;) {
        const bool has_next = S.next(ui + 1, nxt);
        const char* nA = has_next ? (const char*)g.A + (size_t)nxt.pm * tstep : cA; const char* nB = has_next ? (const char*)g.Bt + (size_t)nxt.pn * tstep : cB;
        for (int t = 0; t < nt; t += 2) {
            const bool last = (t == nt - 2);
            const char* a1 = cA + (size_t)(t + 1) * kstep;
            const char* a2 = last ? nA : cA + (size_t)(t + 2) * kstep; const char* b2 = last ? nB : cB + (size_t)(t + 2) * kstep;
            const char* a3 = a2 + kstep; const char* b3 = b2 + kstep;
            if (last && has_next) S.a_ready(nxt);
            if constexpr (SP2) {
            PG8_LDB(B0, 0, 0); PG8_LDB(B1, 0, 1); PG8_SCHED; PG8_LDA(At, 0, 0); PG8_STAGE(PG8_SA(1, 1), a1 + hstep, voffA);
            PG8_WAIT_V(8); PG8_WAIT_L(0); PG8_BAR; PG8_MMA(0, 0, At, B0); PG8_MMA(0, 1, At, B1); PG8_BAR; PG8_SCHED;
            PG8_LDA(At, 0, 1); PG8_STAGE(PG8_SB(0, 0), b2, voffB); PG8_STAGE(PG8_SB(0, 1), b2 + hstep, voffB); PG8_STAGE(PG8_SA(0, 0), a2, voffA);
            PG8_WAIT_V(8); PG8_WAIT_L(0); PG8_BAR; PG8_MMA(1, 0, At, B0); PG8_MMA(1, 1, At, B1); PG8_BAR; PG8_SCHED;
            PG8_LDB(B0, 1, 0); PG8_LDB(B1, 1, 1); PG8_SCHED; PG8_LDA(At, 1, 0); PG8_STAGE(PG8_SA(0, 1), a2 + hstep, voffA);
            PG8_WAIT_V(8); PG8_WAIT_L(0); PG8_BAR; PG8_MMA(0, 0, At, B0); PG8_MMA(0, 1, At, B1); PG8_BAR; PG8_SCHED;
            PG8_LDA(At, 1, 1); PG8_STAGE(PG8_SB(1, 0), b3, voffB); PG8_STAGE(PG8_SB(1, 1), b3 + hstep, voffB); PG8_STAGE(PG8_SA(1, 0), a3, voffA);
            PG8_WAIT_V(8); PG8_WAIT_L(0); PG8_BAR; PG8_MMA(1, 0, At, B0); PG8_MMA(1, 1, At, B1); PG8_BAR; PG8_SCHED;
            } else {
            PG8_LDB(B0, 0, 0); PG8_SCHED; PG8_LDA(At, 0, 0); PG8_STAGE(PG8_SA(1, 1), a1 + hstep, voffA);
            PG8_WAIT_L(8); PG8_BAR; PG8_WAIT_L(0); PG8_MMA(0, 0, At, B0); PG8_BAR; PG8_SCHED;
            PG8_LDB(B1, 0, 1); PG8_STAGE(PG8_SB(0, 0), b2, voffB);
            PG8_BAR; PG8_WAIT_L(0); PG8_MMA(0, 1, At, B1); PG8_BAR;
            PG8_LDA(At, 0, 1); PG8_STAGE(PG8_SA(0, 0), a2, voffA);
            PG8_BAR; PG8_WAIT_L(0); PG8_MMA(1, 0, At, B0); PG8_BAR; PG8_SCHED;
            PG8_STAGE(PG8_SB(0, 1), b2 + hstep, voffB);
            PG8_WAIT_V(6); PG8_BAR; PG8_MMA(1, 1, At, B1); PG8_BAR;
            PG8_LDB(B0, 1, 0); PG8_SCHED; PG8_LDA(At, 1, 0); PG8_STAGE(PG8_SA(0, 1), a2 + hstep, voffA);
            PG8_WAIT_L(8); PG8_BAR; PG8_WAIT_L(0); PG8_MMA(0, 0, At, B0); PG8_BAR; PG8_SCHED;
            PG8_LDB(B1, 1, 1); PG8_STAGE(PG8_SB(1, 0), b3, voffB);
            PG8_BAR; PG8_WAIT_L(0); PG8_MMA(0, 1, At, B1); PG8_BAR;
            PG8_LDA(At, 1, 1); PG8_STAGE(PG8_SA(1, 0), a3, voffA);
            PG8_BAR; PG8_WAIT_L(0); PG8_MMA(1, 0, At, B0); PG8_BAR; PG8_SCHED;
            PG8_STAGE(PG8_SB(1, 1), b3 + hstep, voffB);
            PG8_WAIT_V(6); PG8_BAR; PG8_MMA(1, 1, At, B1); PG8_BAR;
            }
        }
        if constexpr (ALIGN_EPI) { if (wr == 0) PG8_BAR; }
        if constexpr (!Epi::AFTER_DRAIN) { E(acc, cur, wr, wc, fr, fq); S.done(cur); }
        if (!has_next) break;
#pragma unroll
        for (int a = 0; a < 2; ++a)
#pragma unroll
            for (int b = 0; b < 2; ++b)
#pragma unroll
                for (int m = 0; m < 4; ++m)
#pragma unroll
                    for (int n = 0; n < 2; ++n) acc[a][b][m][n] = (f32x4){0.f, 0.f, 0.f, 0.f};
        cur = nxt; cA = nA; cB = nB; ++ui;
        if constexpr (ALIGN_EPI) { if (wr == 1) PG8_BAR; }
    }
    PG8_WAIT_V(0);
    if constexpr (!ALIGN_EPI) { if (wr == 0) PG8_BAR; }
    PG8_BAR;
    if constexpr (Epi::AFTER_DRAIN) { E.fused(acc, cur, wr, wc, fr, fq, lds, wid, lane); S.done(cur); }
#undef PG8_SA
#undef PG8_SB
#undef PG8_STAGE
#undef PG8_LDA
#undef PG8_LDB
#undef PG8_MMA
#undef PG8_WAIT_V
#undef PG8_WAIT_L
#undef PG8_BAR
#undef PG8_SCHED
}
}
using pg8::bf16_t; using pg8::bf16x8; using pg8::f32x4; using pg8::u32x4; using pg8::u32x2;
using pg8::cvt_pk_bf16; using pg8::bflo; using pg8::bfhi; using pg8::sigm; using pg8::gelu_t;
using namespace pg8;
#define LAS __attribute__((address_space(3)))
typedef LAS unsigned char* ldsp;
constexpr int S = 16384, NL = 4, NT = 512;
constexpr int LDS_BYTES = 147456;
constexpr size_t al256(size_t x) { return (x + 255) & ~(size_t)255; }
constexpr size_t WS_SSQ = 0;
constexpr size_t WS_CTR = WS_SSQ + 16 * (size_t)S * 4;
constexpr size_t WS_BIASP = WS_CTR + 1024;
constexpr size_t WS_BAR = al256(WS_BIASP + 16 * 256 * 4);
constexpr size_t WS_LSE = al256(WS_BAR + 16384);
constexpr size_t WS_ATOT = al256(WS_LSE + (size_t)12 * S * 4);
constexpr size_t WS_HEND = WS_ATOT + 256 * 768 * 4;
constexpr size_t WS_KC = WS_HEND + 256 * 768 * 4;
constexpr size_t WS_VCT = WS_KC + 3 * 1024 * 64 * 2;
constexpr size_t WS_WT = al256(WS_VCT + 3 * 1024 * 64 * 2);
constexpr size_t WT_W13A = 0, WT_W2A = WT_W13A + (size_t)5632 * 1024 * 2, WT_WIN = WT_W2A + (size_t)1024 * 2816 * 2, WT_LRU = WT_WIN + (size_t)8960 * 1024 * 2,
                 WT_C1K = WT_LRU + 6 * 256 * 128 * 2, WT_C1V = WT_C1K + 256 * 2048 * 2, WT_C2K = WT_C1V + 256 * 2048 * 2, WT_C2V = WT_C2K + 64 * 256 * 2,
                 WT_UA = WT_C2V + 64 * 256 * 2, WT_UB = WT_UA + 1024 * 768 * 2, WT_UC = WT_UB + 1024 * 768 * 2, WT_WO = WT_UC + 1024 * 256 * 2,
                 WT_W13B = WT_WO + 1024 * 1024 * 2, WT_W2B = WT_W13B + (size_t)5632 * 1024 * 2, WT_END = WT_W2B + (size_t)1024 * 2816 * 2;
constexpr size_t WS_XB = al256(WS_WT + WT_END);
constexpr size_t WS_YA = WS_XB + (size_t)S * 1024 * 2;
constexpr size_t WS_HLOC = WS_YA + (size_t)S * 768 * 2;
constexpr size_t WS_CUMP = WS_HLOC + (size_t)S * 768 * 2;
constexpr size_t WS_NSAO = WS_CUMP + (size_t)S * 768 * 2;
constexpr size_t WS_DILO = WS_NSAO + (size_t)S * 768 * 2;
constexpr size_t WS_VTS = WS_DILO + (size_t)S * 256 * 2;
constexpr size_t WS_VTW = WS_VTS + (size_t)3 * 64 * S * 2;
constexpr size_t WS_VTC = WS_VTW + (size_t)3 * 64 * S * 2;
constexpr size_t WS_MERGED = WS_VTS;
constexpr size_t WS_P = WS_VTC + (size_t)12 * 64 * S * 2;
constexpr size_t WS_HID = WS_P;
constexpr size_t WS_END = WS_P + (size_t)S * PW * 2;
static_assert((size_t)S * 1024 * 2 <= (size_t)18 * 64 * S * 2, "merged fits the VT region");

struct Args { const float* in[29]; float* out; unsigned char* ws; };
enum { I_X = 0, I_F1N, I_F1W1, I_F1W3, I_F1W2, I_MIXN, I_WIN, I_CONVW, I_CONVB, I_LRUWA, I_LRUBA, I_LRUWI, I_LRUBI, I_LAM, I_POSK, I_POSV,
       I_CK1, I_CK2, I_CV1, I_CV2, I_UPA, I_UPB, I_UPC, I_WOUT, I_F2N, I_F2W1, I_F2W3, I_F2W2, I_FINN };

__device__ __forceinline__ const float* inp(int i) {
    const __attribute__((address_space(4))) char* kp = (const __attribute__((address_space(4))) char*)__builtin_amdgcn_kernarg_segment_ptr();
    unsigned off = (unsigned)i * 8u; asm volatile("" : "+s"(off));
    const float* g = *(const float* const __attribute__((address_space(4)))*)(kp + off);
    return (const float*)(const __attribute__((address_space(1))) float*)g;
}
__device__ __forceinline__ float wave_sum(float v) {
#pragma unroll
    for (int o = 1; o < 64; o <<= 1) v += __shfl_xor(v, o);
    return v;
}
__device__ __forceinline__ f32x4 mfma16(bf16x8 a, bf16x8 b, f32x4 c) { return __builtin_amdgcn_mfma_f32_16x16x32_bf16(a, b, c, 0, 0, 0); }

#define XB_TMO      128
#define XB_XCNT(j)  (256  + 64 * (j))
#define XB_XSUB(j)  (1280 + 64 * (j))
#define XB_XGEN(j)  (2304 + 64 * (j))
#define XB_TOP      3328
#define XB_TOPGEN   3392
#define XCD_BAR_WORDS 3456
#define XB_SPIN_CAP (1u << 22)

__device__ __forceinline__ unsigned xb_ld(unsigned* p)              { return __hip_atomic_load(p, __ATOMIC_RELAXED, __HIP_MEMORY_SCOPE_AGENT); }
__device__ __forceinline__ unsigned xb_add(unsigned* p, unsigned v) { return __hip_atomic_fetch_add(p, v, __ATOMIC_RELAXED, __HIP_MEMORY_SCOPE_AGENT); }
__device__ __forceinline__ unsigned xb_xcc_id() { return (unsigned)__builtin_amdgcn_s_getreg((3 << 11) | 20) & 0xFu; }
#define XB_SPIN(cond, bar) do { unsigned _sp = 0; while (cond) { __builtin_amdgcn_s_sleep(1); \
    if ((++_sp & 255u) == 0u) { if (xb_ld(&(bar)[XB_TMO])) break; if (_sp > XB_SPIN_CAP) { atomicAdd(&(bar)[XB_TMO], 1u); break; } } } } while (0)

struct XcdBarrier {
    unsigned* bar; unsigned x;
    volatile LAS unsigned* st;
};

__device__ __forceinline__ XcdBarrier xcd_barrier_post(unsigned* bar, volatile LAS unsigned* st) {
    XcdBarrier b; b.bar = bar; b.x = xb_xcc_id(); b.st = st;
    if (threadIdx.x == 0) (void)xb_add(&bar[XB_XCNT(b.x)], 1u);
    return b;
}
__device__ __forceinline__ void xcd_barrier_complete(unsigned* bar, unsigned x, unsigned& nloc, unsigned& nx) {
    const unsigned G = gridDim.x * gridDim.y * gridDim.z;
    unsigned sum, cnt, mine, sp = 0u;
    for (;;) {
        sum = 0u; cnt = 0u; mine = 0u;
#pragma unroll
        for (unsigned j = 0; j < 16; ++j) { const unsigned c = xb_ld(&bar[XB_XCNT(j)]); sum += c; cnt += (c > 0u) ? 1u : 0u; mine = (j == x) ? c : mine; }
        if (sum == G) break;
        __builtin_amdgcn_s_sleep(1);
        if ((++sp & 255u) == 0u) { if (xb_ld(&bar[XB_TMO])) break; if (sp > XB_SPIN_CAP) { atomicAdd(&bar[XB_TMO], 1u); break; } }
    }
    nloc = mine > 0u ? mine : 1u; nx = cnt > 0u ? cnt : 1u;
}

__device__ __forceinline__ void xcd_barrier(const XcdBarrier& b) {
    asm volatile("s_waitcnt vmcnt(0)" ::: "memory");
    __syncthreads();
    if (threadIdx.x == 0) {
        unsigned* bar = b.bar;
        __builtin_amdgcn_s_waitcnt(0);
        unsigned nloc = b.st[0], nx = b.st[1];
        if (nloc == 0u) { xcd_barrier_complete(bar, b.x, nloc, nx); b.st[0] = nloc; b.st[1] = nx; }
        const unsigned old = xb_add(&bar[XB_XSUB(b.x)], 1u);
        const unsigned gen = old / nloc;
        if (old + 1u == (gen + 1u) * nloc) {
            __builtin_amdgcn_fence(__ATOMIC_RELEASE, "agent");
            asm volatile("s_waitcnt vmcnt(0)" ::: "memory");
            const unsigned og = xb_add(&bar[XB_TOP], 1u);
            const unsigned tg = og / nx;
            if (og + 1u == (tg + 1u) * nx) xb_add(&bar[XB_TOPGEN], 1u);
            else XB_SPIN(xb_ld(&bar[XB_TOPGEN]) == tg, bar);
            __builtin_amdgcn_fence(__ATOMIC_ACQUIRE, "agent");
            xb_add(&bar[XB_XGEN(b.x)], 1u);
            asm volatile("s_waitcnt vmcnt(0)" ::: "memory");
        } else {
            XB_SPIN(xb_ld(&bar[XB_XGEN(b.x)]) == gen, bar);
            __builtin_amdgcn_fence(__ATOMIC_ACQUIRE, "agent");
            asm volatile("s_waitcnt vmcnt(0)" ::: "memory");
        }
    }
    __syncthreads();
}

template <class RowF>
__device__ __forceinline__ void tr_item(const float* src, int ldn, int nsrc, const float* gk, bf16_t* WT, int K, int item, int nblk, LAS float* scr, int lane, RowF rowmap) {
    const int kb = item / nblk, nb = item % nblk, k0 = 64 * kb, n0 = 32 * nb;
    const int nq = n0 + 4 * (lane & 7); const bool okc = nq + 3 < nsrc; const float* cp = src + (okc ? nq : 0);
#pragma unroll
    for (int i = 0; i < 8; ++i) { const int kk = 8 * i + (lane >> 3); f32x4 v = okc ? *(const f32x4*)(cp + (size_t)(k0 + kk) * ldn) : (f32x4){0.f, 0.f, 0.f, 0.f}; if (gk) v = v * gk[k0 + kk];
        LAS float* d = scr + kk * 33 + 4 * (lane & 7); d[0] = v[0]; d[1] = v[1]; d[2] = v[2]; d[3] = v[3]; }
    asm volatile("s_waitcnt lgkmcnt(0)" ::: "memory");
    const int c = lane & 7;
#pragma unroll
    for (int j = 0; j < 4; ++j) { const int n = (lane >> 3) + 8 * j; const LAS float* s = scr + (8 * c) * 33 + n;
        u32x4 o; o.x = cvt_pk_bf16(s[0 * 33], s[1 * 33]); o.y = cvt_pk_bf16(s[2 * 33], s[3 * 33]); o.z = cvt_pk_bf16(s[4 * 33], s[5 * 33]); o.w = cvt_pk_bf16(s[6 * 33], s[7 * 33]);
        if (n0 + n < nsrc) *(u32x4*)(WT + (size_t)rowmap(n0 + n) * K + k0 + 8 * c) = o; }
    asm volatile("s_waitcnt lgkmcnt(0)" ::: "memory");
}
__device__ __forceinline__ int rm_id(int n) { return n; }
constexpr int PN1 = 16 * 88, PN2 = 44 * 32, PNIN = 16 * 278, PNLR = 6 * 8, PNC1 = 32 * 8, PNC2 = 4 * 2, PNUA = 12 * 32, PNUC = 4 * 32, PNWO = 16 * 32;
constexpr int PREP_GA = 2 * PN1 + PN2 + PNIN, PREP_GB = 2 * PNLR + 2 * PNC1 + 2 * PNC2 + 16 * 8 + 8, PREP_GC = 2 * PNUA + PNUC + PNWO + 2 * PN1 + PN2;
constexpr int PREP_GA_B = (PREP_GA + 7) / 8, PREP_GB_B = (PREP_GB + 7) / 8, PREP_GC_B = (PREP_GC + 7) / 8;
__device__ __forceinline__ void prep_wave_item(unsigned char* ws, int l, int grp, int r, LAS float* scr, int lane) {
    unsigned char* wt = ws + WS_WT;
    auto rm13a = [](int j) { return (j >> 2) * 8 + (j & 3); };
    auto rm13b = [](int j) { return (j >> 2) * 8 + 4 + (j & 3); };
    auto rmin = [](int o) { return o < 2304 ? o : o < 3456 ? o - 2304 + 7680 : o < 3492 ? o - 3456 + 8832 : o < 5796 ? o - 3492 + 2304 : o - 5796 + 4608; };
    if (grp == 0) {
        if (r < PN1) { tr_item(inp(I_F1W1) + (size_t)l * DM * DFF, DFF, DFF, inp(I_F1N) + l * DM, (bf16_t*)(wt + WT_W13A), 1024, r, 88, scr, lane, rm13a); return; } r -= PN1;
        if (r < PN1) { tr_item(inp(I_F1W3) + (size_t)l * DM * DFF, DFF, DFF, inp(I_F1N) + l * DM, (bf16_t*)(wt + WT_W13A), 1024, r, 88, scr, lane, rm13b); return; } r -= PN1;
        if (r < PN2) { tr_item(inp(I_F1W2) + (size_t)l * DFF * DM, DM, DM, nullptr, (bf16_t*)(wt + WT_W2A), 2816, r, 32, scr, lane, rm_id); return; } r -= PN2;
        if (r < PNIN) { tr_item(inp(I_WIN) + (size_t)l * DM * 8868, 8868, 8868, inp(I_MIXN) + l * DM, (bf16_t*)(wt + WT_WIN), 1024, r, 278, scr, lane, rmin); }
    } else if (grp == 1) {
        if (r < PNLR) { const int b = r / 8, rr = r % 8; tr_item(inp(I_LRUWA) + (size_t)l * 98304 + b * 16384, 128, 128, nullptr, (bf16_t*)(wt + WT_LRU) + b * 256 * 128, 128, rr, 4, scr, lane, rm_id); return; } r -= PNLR;
        if (r < PNLR) { const int b = r / 8, rr = r % 8; tr_item(inp(I_LRUWI) + (size_t)l * 98304 + b * 16384, 128, 128, nullptr, (bf16_t*)(wt + WT_LRU) + b * 256 * 128 + 128 * 128, 128, rr, 4, scr, lane, rm_id); return; } r -= PNLR;
        if (r < PNC1) { tr_item(inp(I_CK1) + (size_t)l * 2048 * 256, 256, 256, nullptr, (bf16_t*)(wt + WT_C1K), 2048, r, 8, scr, lane, rm_id); return; } r -= PNC1;
        if (r < PNC1) { tr_item(inp(I_CV1) + (size_t)l * 2048 * 256, 256, 256, nullptr, (bf16_t*)(wt + WT_C1V), 2048, r, 8, scr, lane, rm_id); return; } r -= PNC1;
        if (r < PNC2) { tr_item(inp(I_CK2) + (size_t)l * 256 * 64, 64, 64, nullptr, (bf16_t*)(wt + WT_C2K), 256, r, 2, scr, lane, rm_id); return; } r -= PNC2;
        if (r < PNC2) { tr_item(inp(I_CV2) + (size_t)l * 256 * 64, 64, 64, nullptr, (bf16_t*)(wt + WT_C2V), 256, r, 2, scr, lane, rm_id); return; } r -= PNC2;
        if (r < 128) {
            const int pb = r >> 3, wv = r & 7, kv = pb >> 3, part = pb & 7;
            if (lane < 32) { const int j = wv * 32 + lane;
                const float* pos = inp(kv ? I_POSV : I_POSK) + (size_t)l * 2048 + part * 256; const float* w1 = inp(kv ? I_CV1 : I_CK1) + (size_t)l * 2048 * 256 + (size_t)part * 256 * 256 + j;
                float s = 0.f;
#pragma unroll 8
                for (int kk = 0; kk < 256; ++kk) s += pos[kk] * w1[(size_t)kk * 256];
                ((float*)(ws + WS_BIASP))[pb * 256 + j] = s; }
            return; } r -= 128;
        if (r < 8) {
            u32x4* z = (u32x4*)((bf16_t*)(wt + WT_WIN) + (size_t)8868 * 1024); const int nz = 92 * 1024 * 2 / 16;
            unsigned zz = 0u; asm volatile("" : "+v"(zz));
            for (int i = r * 64 + lane; i < nz; i += 512) z[i] = (u32x4){zz, zz, zz, zz}; }
    } else {
        if (r < PNUA) { tr_item(inp(I_UPA) + (size_t)l * 768 * 1024, 1024, 1024, nullptr, (bf16_t*)(wt + WT_UA), 768, r, 32, scr, lane, rm_id); return; } r -= PNUA;
        if (r < PNUA) { tr_item(inp(I_UPB) + (size_t)l * 768 * 1024, 1024, 1024, nullptr, (bf16_t*)(wt + WT_UB), 768, r, 32, scr, lane, rm_id); return; } r -= PNUA;
        if (r < PNUC) { tr_item(inp(I_UPC) + (size_t)l * 256 * 1024, 1024, 1024, nullptr, (bf16_t*)(wt + WT_UC), 256, r, 32, scr, lane, rm_id); return; } r -= PNUC;
        if (r < PNWO) { tr_item(inp(I_WOUT) + (size_t)l * 1024 * 1024, 1024, 1024, nullptr, (bf16_t*)(wt + WT_WO), 1024, r, 32, scr, lane, rm_id); return; } r -= PNWO;
        if (r < PN1) { tr_item(inp(I_F2W1) + (size_t)l * DM * DFF, DFF, DFF, inp(I_F2N) + l * DM, (bf16_t*)(wt + WT_W13B), 1024, r, 88, scr, lane, rm13a); return; } r -= PN1;
        if (r < PN1) { tr_item(inp(I_F2W3) + (size_t)l * DM * DFF, DFF, DFF, inp(I_F2N) + l * DM, (bf16_t*)(wt + WT_W13B), 1024, r, 88, scr, lane, rm13b); return; } r -= PN1;
        if (r < PN2) { tr_item(inp(I_F2W2) + (size_t)l * DFF * DM, DM, DM, nullptr, (bf16_t*)(wt + WT_W2B), 2816, r, 32, scr, lane, rm_id); }
    }
}
__device__ __forceinline__ void prep_block_item(unsigned char* ws, int l, int grp, int bitem, ldsp lds, int tid) {
    asm volatile("" : "+v"(tid));
    const int lane = tid & 63, wave = __builtin_amdgcn_readfirstlane(tid >> 6);
    const int r = bitem * 8 + wave; const int cnt = grp == 0 ? PREP_GA : grp == 1 ? PREP_GB : PREP_GC;
    if (r < cnt) prep_wave_item(ws, l, grp, r, (LAS float*)(lds + wave * 8448), lane);
}
__device__ __forceinline__ void prep_phase(unsigned char* ws, int l, int grp, ldsp lds, int tid) {
    const int nb = grp == 0 ? PREP_GA_B : grp == 1 ? PREP_GB_B : PREP_GC_B;
    for (int b = blockIdx.x; b < nb; b += gridDim.x) prep_block_item(ws, l, grp, b, lds, tid);
}

struct FState { float m, l; f32x4 o[4]; };
__device__ __forceinline__ void fs_init(FState& st) { st.m = -1e30f; st.l = 0.f;
#pragma unroll
    for (int i = 0; i < 4; ++i) st.o[i] = (f32x4){0.f, 0.f, 0.f, 0.f}; }
constexpr int KV_BUF = 16384, NKVB = 3;
__device__ __forceinline__ int k_swz(int row) { return ((row >> 1) & 7) ^ (((row >> 4) & 1) << 1); }
struct KvOff { int k[2][2]; int v[2]; };
__device__ __forceinline__ KvOff kv_offsets(int c, int q) { KvOff o; const int rb = 8 * (c >> 2) + (c & 3);
#pragma unroll
    for (int b = 0; b < 2; ++b)
#pragma unroll
        for (int ks = 0; ks < 2; ++ks) { const int row = rb + 4 * b; o.k[ks][b] = row * 128 + (((ks * 4 + q) ^ k_swz(row)) * 16); }
#pragma unroll
    for (int k2 = 0; k2 < 2; ++k2) o.v[k2] = 8192 + c * 128 + (((4 * k2 + q) ^ ((c >> 1) & 7)) * 16);
    return o; }
__device__ __forceinline__ void qk_tile(ldsp B, const KvOff& ko, const bf16x8 (&qf)[2], f32x4 (&s)[4], f32x4 cinit) {
#pragma unroll
    for (int kt = 0; kt < 4; ++kt) { const bf16x8 a0 = *(const LAS bf16x8*)(B + ko.k[0][kt & 1] + (kt >> 1) * 4096), a1 = *(const LAS bf16x8*)(B + ko.k[1][kt & 1] + (kt >> 1) * 4096);
        s[kt] = mfma16(a0, qf[0], cinit); s[kt] = mfma16(a1, qf[1], s[kt]); }
}
#define KLOC(kt, r) (32 * ((kt) >> 1) + 4 * ((kt) & 1) + (r))
__device__ __forceinline__ void pv_tile(ldsp B, const KvOff& ko, const f32x4 (&p)[4], f32x4 (&o)[4], bool colok = true) {
#pragma unroll
    for (int k2 = 0; k2 < 2; ++k2) {
        u32x4 pw; pw.x = cvt_pk_bf16(p[2 * k2][0], p[2 * k2][1]); pw.y = cvt_pk_bf16(p[2 * k2][2], p[2 * k2][3]); pw.z = cvt_pk_bf16(p[2 * k2 + 1][0], p[2 * k2 + 1][1]); pw.w = cvt_pk_bf16(p[2 * k2 + 1][2], p[2 * k2 + 1][3]);
        pw.x = colok ? pw.x : 0u; pw.y = colok ? pw.y : 0u; pw.z = colok ? pw.z : 0u; pw.w = colok ? pw.w : 0u;
        const bf16x8 pb = __builtin_bit_cast(bf16x8, pw);
#pragma unroll
        for (int dt = 0; dt < 4; ++dt) o[dt] = mfma16(*(const LAS bf16x8*)(B + ko.v[k2] + dt * 2048), pb, o[dt]); }
}
__device__ __forceinline__ float quad_sum(float v) {
    v += __int_as_float(__builtin_amdgcn_update_dpp(0, __float_as_int(v), 0xB1, 0xF, 0xF, true));
    v += __int_as_float(__builtin_amdgcn_update_dpp(0, __float_as_int(v), 0x4E, 0xF, 0xF, true));
    return v; }
__device__ __forceinline__ float colmax4(float m) {
    { const auto rr = __builtin_amdgcn_permlane16_swap(__float_as_uint(m), __float_as_uint(m), false, false); m = fmaxf(__uint_as_float(rr[0]), __uint_as_float(rr[1])); }
    { const auto rr = __builtin_amdgcn_permlane32_swap(__float_as_uint(m), __float_as_uint(m), false, false); m = fmaxf(__uint_as_float(rr[0]), __uint_as_float(rr[1])); }
    return m;
}
template <int MK, class MaskF>
__device__ __forceinline__ void flash_step(ldsp B, const KvOff& ko, const bf16x8 (&qf)[2], FState& st, bool colok, MaskF mk) {
    const bool fresh = st.m <= -1e29f; const float mu = fresh ? 0.f : st.m;
    const f32x4 negm = (f32x4){-mu, -mu, -mu, -mu};
    f32x4 s[4]; qk_tile(B, ko, qf, s, negm);
    if (MK == 1) {
#pragma unroll
        for (int kt = 0; kt < 4; ++kt)
#pragma unroll
            for (int r = 0; r < 4; ++r) s[kt][r] = mk(KLOC(kt, r)) ? s[kt][r] : -1e30f; }
    float mx = fmaxf(fmaxf(s[0][0], s[0][1]), fmaxf(s[0][2], s[0][3]));
#pragma unroll
    for (int kt = 1; kt < 4; ++kt) mx = fmaxf(fmaxf(mx, s[kt][0]), fmaxf(fmaxf(s[kt][1], s[kt][2]), s[kt][3]));
    if (MK == 2) mx = colok ? mx : -1e30f;
    const bool need = fresh ? (mx > -1e29f) : (mx > 8.0f);
    if (__any(need)) {
        const float mc = colmax4(mx);
        const bool none = fresh && mc <= -1e29f;
        const float delta = none ? 0.f : (fresh ? mc : fmaxf(mc, 0.f));
        st.m = none ? st.m : mu + delta;
        const float alpha = __builtin_amdgcn_exp2f(-delta); st.l *= alpha;
#pragma unroll
        for (int dt = 0; dt < 4; ++dt) st.o[dt] = st.o[dt] * alpha;
#pragma unroll
        for (int kt = 0; kt < 4; ++kt) s[kt] = s[kt] - delta;
    }
    float rs = 0.f;
#pragma unroll
    for (int kt = 0; kt < 4; ++kt)
#pragma unroll
        for (int r = 0; r < 4; ++r) s[kt][r] = __builtin_amdgcn_exp2f(s[kt][r]);
#pragma unroll
    for (int kt = 0; kt < 4; ++kt) rs += (s[kt][0] + s[kt][1]) + (s[kt][2] + s[kt][3]);
    st.l += (MK == 2 && !colok) ? 0.f : rs;
    pv_tile(B, ko, s, st.o, (MK == 2) ? colok : true);
}
__device__ __forceinline__ void glds16(const void* gsrc, unsigned lds_dst) { unsigned keep;
    asm volatile("s_mov_b32 %0, m0\n\ts_mov_b32 m0, %2\n\ts_nop 0\n\tglobal_load_lds_dwordx4 %1, off\n\ts_mov_b32 m0, %0" : "=&s"(keep) : "v"(gsrc), "s"(lds_dst) : "memory"); }
template <class BodyF>
__device__ __forceinline__ void kv_loop(ldsp lds, const bf16_t* Kg, size_t kpitch, int kmaxrow, const bf16_t* VTg, size_t vtpitch, int kb0, int kb1, int tid, BodyF body) {
    asm volatile("" : "+v"(tid));
    const int r = tid >> 3, sc = (tid & 7) ^ ((r >> 1) & 7), sck = (tid & 7) ^ k_swz(r);
    const unsigned ldsw = (unsigned)__builtin_amdgcn_readfirstlane((int)(unsigned)(unsigned long long)lds + (tid >> 6) * 1024);
    const bf16_t* vsrc = VTg + (size_t)r * vtpitch + sc * 8;
    auto issue = [&](int kb, unsigned slot) { int row = kb * 64 + r; row = row < kmaxrow ? row : kmaxrow;
        glds16(Kg + (size_t)row * kpitch + sck * 8, ldsw + slot); glds16(vsrc + kb * 64, ldsw + slot + 8192); };
    if (kb0 < kb1) issue(kb0, 0u);
    if (kb0 + 1 < kb1) issue(kb0 + 1, (unsigned)KV_BUF);
    unsigned cs = 0u, ns = 2u * KV_BUF;
    for (int kb = kb0; kb < kb1; ++kb) {
        if (kb + 1 < kb1) asm volatile("s_waitcnt vmcnt(2) lgkmcnt(0)\n\ts_barrier" ::: "memory");
        else asm volatile("s_waitcnt vmcnt(0) lgkmcnt(0)\n\ts_barrier" ::: "memory");
        if (kb + 2 < kb1) issue(kb + 2, ns);
        body(kb, lds + cs);
        cs = cs == 2u * KV_BUF ? 0u : cs + KV_BUF; ns = ns == 2u * KV_BUF ? 0u : ns + KV_BUF;
    }
    asm volatile("s_waitcnt vmcnt(0) lgkmcnt(0)\n\ts_barrier" ::: "memory");
}
template <int CH, class BodyF>
__device__ __forceinline__ void kv_loop_chunked(ldsp lds, const bf16_t* Kg, size_t kpitch, int kmaxrow, const bf16_t* VTg, size_t vtpitch, int kb0, int kb1, int tid, BodyF body) {
    asm volatile("" : "+v"(tid));
    const int r = tid >> 3, sc = (tid & 7) ^ ((r >> 1) & 7);
    const unsigned ldsw = (unsigned)__builtin_amdgcn_readfirstlane((int)(unsigned)(unsigned long long)lds + (tid >> 6) * 1024);
    const bf16_t* vsrc = VTg + (size_t)r * vtpitch + sc * 8;
    auto issue_chunk = [&](int kbc, unsigned half) {
#pragma unroll
        for (int j = 0; j < CH; ++j) { const int kb = kbc + j; if (kb < kb1) { int row = kb * 64 + r; row = row < kmaxrow ? row : kmaxrow; const unsigned slot = half + (unsigned)j * KV_BUF;
            glds16(Kg + (size_t)row * kpitch + sc * 8, ldsw + slot); glds16(vsrc + kb * 64, ldsw + slot + 8192); } } };
    if (kb0 < kb1) issue_chunk(kb0, 0u);
    unsigned half = 0u;
    for (int kbc = kb0; kbc < kb1; kbc += CH) {
        asm volatile("s_waitcnt vmcnt(0) lgkmcnt(0)\n\ts_barrier" ::: "memory");
        if (kbc + CH < kb1) issue_chunk(kbc + CH, half ^ (unsigned)(CH * KV_BUF));
#pragma unroll 1
        for (int j = 0; j < CH; ++j) { const int kb = kbc + j; if (kb < kb1) body(kb, lds + half + j * KV_BUF); }
        half ^= (unsigned)(CH * KV_BUF);
    }
    asm volatile("s_waitcnt vmcnt(0) lgkmcnt(0)\n\ts_barrier" ::: "memory");
}
__device__ __forceinline__ float fs_ltot(const FState& st) { float l = st.l; l += __shfl_xor(l, 16); l += __shfl_xor(l, 32); return l; }

constexpr int NG = 2;
template <int MODE>
__device__ __forceinline__ void nsa_item(unsigned char* ws, ldsp lds, int tile, int kh, int tid) {
    asm volatile("" : "+v"(tid));
    const int lane = tid & 63, wave = __builtin_amdgcn_readfirstlane(tid >> 6), c = lane & 15, q = lane >> 4;
    const int t0 = tile * 64, tk = c >> 2, g = c & 3, hq = kh * 4 + g, cur = tile;
    const bf16_t* P = (const bf16_t*)(ws + WS_P);
    LAS float* imp = (LAS float*)(lds + NKVB * KV_BUF) + wave * (NG * 4 * 256);
    LAS unsigned* selm = (LAS unsigned*)(lds + 8 * KV_BUF) + wave * (NG * 4 * 8);
    const KvOff ko = kv_offsets(c, q);
    int t[NG]; bf16x8 qf[NG][2];
#pragma unroll
    for (int gi = 0; gi < NG; ++gi) { t[gi] = t0 + wave * (4 * NG) + gi * 4 + tk;
#pragma unroll
        for (int ks = 0; ks < 2; ++ks) qf[gi][ks] = *(const bf16x8*)(P + (size_t)t[gi] * PW + PC_BQ + hq * 64 + ks * 32 + q * 8); }
    const bf16_t* KC = (const bf16_t*)(ws + WS_KC) + (size_t)kh * 1024 * 64; const bf16_t* VCT = (const bf16_t*)(ws + WS_VCT) + (size_t)kh * 64 * 1024;
    const int nkbc = (t0 >> 10) + 1;
    float cm[NG], cl[NG];
#pragma unroll
    for (int gi = 0; gi < NG; ++gi) { cm[gi] = -1e30f; cl[gi] = 0.f; }
    if (MODE & 1) kv_loop(lds, KC, 64, 1023, VCT, 1024, 0, nkbc, tid, [&](int kb, ldsp B) {
#pragma unroll
        for (int gi = 0; gi < NG; ++gi) {
            f32x4 s[4]; qk_tile(B, ko, qf[gi], s, (f32x4){0.f, 0.f, 0.f, 0.f}); float mx = -1e30f; const int lim = ((t[gi] - 31) >> 4) - kb * 64 - 8 * q;
#pragma unroll
            for (int kt = 0; kt < 4; ++kt)
#pragma unroll
                for (int r = 0; r < 4; ++r) { const bool v = (KLOC(kt, r) <= lim); s[kt][r] = v ? s[kt][r] : -1e30f; mx = fmaxf(mx, s[kt][r]); }
            mx = colmax4(mx);
            const float mn = fmaxf(cm[gi], mx); const float alpha = __builtin_amdgcn_exp2f(cm[gi] - mn); cm[gi] = mn; float rs = 0.f;
#pragma unroll
            for (int kt = 0; kt < 4; ++kt)
#pragma unroll
                for (int r = 0; r < 4; ++r) rs += (s[kt][r] > -1e29f) ? __builtin_amdgcn_exp2f(s[kt][r] - mn) : 0.f;
            cl[gi] = cl[gi] * alpha + rs; }
    });
#pragma unroll
    for (int gi = 0; gi < NG; ++gi) { float lt = cl[gi]; lt += __shfl_xor(lt, 16); lt += __shfl_xor(lt, 32); cl[gi] = lt > 0.f ? 1.f / lt : 0.f; }
    {
    f32x4 fin[NG][4];
#pragma unroll
    for (int gi = 0; gi < NG; ++gi)
#pragma unroll
        for (int i = 0; i < 4; ++i) fin[gi][i] = (f32x4){0.f, 0.f, 0.f, 0.f};
    if (MODE & 1) kv_loop(lds, KC, 64, 1023, VCT, 1024, 0, nkbc, tid, [&](int kb, ldsp B) {
#pragma unroll
        for (int gi = 0; gi < NG; ++gi) {
            f32x4 s[4]; qk_tile(B, ko, qf[gi], s, (f32x4){0.f, 0.f, 0.f, 0.f}); const int lim = ((t[gi] - 31) >> 4) - kb * 64 - 8 * q;
#pragma unroll
            for (int kt = 0; kt < 4; ++kt) { float ps = 0.f;
#pragma unroll
                for (int r = 0; r < 4; ++r) { const bool v = (KLOC(kt, r) <= lim); const float p = v ? __builtin_amdgcn_exp2f(s[kt][r] - cm[gi]) * cl[gi] : 0.f; s[kt][r] = p; ps += p; }
                ps = quad_sum(ps);
                if (g == 0) imp[(gi * 4 + tk) * 256 + kb * 16 + 8 * (kt >> 1) + 2 * q + (kt & 1)] = ps; }
            pv_tile(B, ko, s, fin[gi]); }
    });
#pragma unroll
    for (int gi = 0; gi < NG; ++gi) { const float g0 = sigm(bflo((unsigned)P[(size_t)t[gi] * PW + PC_BG + hq * 3])); bf16_t* O = (bf16_t*)(ws + WS_NSAO) + (size_t)t[gi] * 768 + hq * 64;
#pragma unroll
        for (int dt = 0; dt < 4; ++dt) { const f32x4 v = fin[gi][dt] * g0; u32x2 w; w.x = cvt_pk_bf16(v[0], v[1]); w.y = cvt_pk_bf16(v[2], v[3]); if ((MODE & 16) || v[0] == 12345.678f) *(u32x2*)(O + dt * 16 + 4 * q) = w; } }
    }
    asm volatile("s_waitcnt lgkmcnt(0)" ::: "memory");
    if (MODE & 2)
#pragma unroll 2
    for (int tt = 0; tt < NG * 4; ++tt) {
        LAS float* im = imp + tt * 256;
        unsigned vb[4];
#pragma unroll
        for (int i = 0; i < 4; ++i) { const int n = lane + 64 * i; const float f = im[n]; vb[i] = (n <= cur) ? ((n == 0 || n == cur) ? 0x4e6e6b28u   : __float_as_uint(f)) : 0u; }
        unsigned long long selb[4];
        if (cur < 16) {
#pragma unroll
            for (int i = 0; i < 4; ++i) selb[i] = __ballot(lane + 64 * i <= cur);
        } else {
            unsigned thr = 0u; bool exact = false;
            for (int b = 30; b >= 0; --b) { const unsigned cand = thr | (1u << b); int cnt = 0;
#pragma unroll
                for (int i = 0; i < 4; ++i) cnt += __builtin_popcountll(__ballot(vb[i] >= cand));
                if (cnt >= 16) { thr = cand; if (cnt == 16) { exact = true; break; } } }
            if (exact) {
#pragma unroll
                for (int i = 0; i < 4; ++i) selb[i] = __ballot(vb[i] >= thr);
            } else {
            int ngt = 0;
#pragma unroll
            for (int i = 0; i < 4; ++i) ngt += __builtin_popcountll(__ballot(vb[i] > thr));
            int need = 16 - ngt;
#pragma unroll
            for (int i = 0; i < 4; ++i) { const unsigned long long eq = __ballot(vb[i] == thr && lane + 64 * i <= cur); const unsigned long long below = eq & ((1ull << lane) - 1ull);
                const bool take = (vb[i] == thr) && (lane + 64 * i <= cur) && ((int)__builtin_popcountll(below) < need);
                selb[i] = __ballot((vb[i] > thr) || take); need -= (int)__builtin_popcountll(eq); need = need < 0 ? 0 : need; }
            }
        }
#pragma unroll
        for (int i = 0; i < 4; ++i) if (lane == 0) { selm[tt * 8 + 2 * i] = (unsigned)selb[i]; selm[tt * 8 + 2 * i + 1] = (unsigned)(selb[i] >> 32); }
    }
    asm volatile("s_waitcnt lgkmcnt(0)" ::: "memory");
    if (MODE & 4) {
        LAS unsigned* sm_all = (LAS unsigned*)(lds + 8 * KV_BUF);
        ldsp QT = lds;
        LAS int* OACC = (LAS int*)(lds + 49152);
        LAS int* LACC = (LAS int*)(lds + 49152 + 256 * 272); LAS float* MREF = (LAS float*)(LACC + 256);
        const bf16_t* Kg = P + PC_KS + kh * 64; const bf16_t* VTg = (const bf16_t*)(ws + WS_VTS) + (size_t)kh * 64 * S;
        __syncthreads();
#pragma unroll
        for (int gi = 0; gi < NG; ++gi) { const int row = (wave * (4 * NG) + gi * 4 + tk) * 4 + g, sw = (row >> 1) & 7;
#pragma unroll
            for (int ks = 0; ks < 2; ++ks) *(LAS bf16x8*)(QT + row * 128 + (((ks * 4 + q) ^ sw) * 16)) = qf[gi][ks]; }
        for (int i = tid; i < 256 * 68 + 256; i += NT) OACC[i] = 0;
        __syncthreads();
        auto block_step = [&](int kb, const bf16x8 (&kf)[4][2], const u32x4 (&vf)[4][2], int rowv, bool colok, bool diag, int tq, bool setref) {
            const int sw = (rowv >> 1) & 7;
            const bf16x8 q0 = *(const LAS bf16x8*)(QT + rowv * 128 + ((q ^ sw) * 16)), q1 = *(const LAS bf16x8*)(QT + rowv * 128 + (((4 + q) ^ sw) * 16));
            const float cin = setref ? 0.f : 10.f - MREF[rowv];
            const f32x4 cinit = (f32x4){cin, cin, cin, cin};
            f32x4 s[4];
#pragma unroll
            for (int kt = 0; kt < 4; ++kt) { s[kt] = mfma16(kf[kt][0], q0, cinit); s[kt] = mfma16(kf[kt][1], q1, s[kt]); }
            if (diag) { const int lim = tq - kb * 64 - 8 * q;
#pragma unroll
                for (int kt = 0; kt < 4; ++kt)
#pragma unroll
                    for (int r = 0; r < 4; ++r) s[kt][r] = (32 * (kt >> 1) + 4 * (kt & 1) + r <= lim) ? s[kt][r] : -1e30f; }
            if (setref) { float mx = fmaxf(fmaxf(s[0][0], s[0][1]), fmaxf(s[0][2], s[0][3]));
#pragma unroll
                for (int kt = 1; kt < 4; ++kt) mx = fmaxf(fmaxf(mx, s[kt][0]), fmaxf(fmaxf(s[kt][1], s[kt][2]), s[kt][3]));
                const float mref = colmax4(mx); if (q == 0) MREF[rowv] = mref;
                const float d = mref - 10.f;
#pragma unroll
                for (int kt = 0; kt < 4; ++kt) s[kt] = s[kt] - d; }
            float rs = 0.f;
#pragma unroll
            for (int kt = 0; kt < 4; ++kt) {
#pragma unroll
                for (int r = 0; r < 4; ++r) s[kt][r] = __builtin_amdgcn_exp2f(s[kt][r]);
                rs += (s[kt][0] + s[kt][1]) + (s[kt][2] + s[kt][3]); }
            { const auto rr = __builtin_amdgcn_permlane16_swap(__float_as_uint(rs), __float_as_uint(rs), false, false); rs = __uint_as_float(rr[0]) + __uint_as_float(rr[1]); }
            { const auto rr = __builtin_amdgcn_permlane32_swap(__float_as_uint(rs), __float_as_uint(rs), false, false); rs = __uint_as_float(rr[0]) + __uint_as_float(rr[1]); }
            if (q == 0 && colok) __hip_atomic_fetch_add(LACC + rowv, __float2int_rn(rs), __ATOMIC_RELAXED, __HIP_MEMORY_SCOPE_WORKGROUP);
            f32x4 o[4];
#pragma unroll
            for (int dt = 0; dt < 4; ++dt) o[dt] = (f32x4){0.f, 0.f, 0.f, 0.f};
#pragma unroll
            for (int k2 = 0; k2 < 2; ++k2) { u32x4 pw; pw.x = cvt_pk_bf16(s[2 * k2][0], s[2 * k2][1]); pw.y = cvt_pk_bf16(s[2 * k2][2], s[2 * k2][3]); pw.z = cvt_pk_bf16(s[2 * k2 + 1][0], s[2 * k2 + 1][1]); pw.w = cvt_pk_bf16(s[2 * k2 + 1][2], s[2 * k2 + 1][3]);
                const bf16x8 pb = __builtin_bit_cast(bf16x8, pw);
#pragma unroll
                for (int dt = 0; dt < 4; ++dt) o[dt] = mfma16(__builtin_bit_cast(bf16x8, vf[dt][k2]), pb, o[dt]); }
            if (colok) {
#pragma unroll
                for (int dt = 0; dt < 4; ++dt)
#pragma unroll
                    for (int r = 0; r < 4; ++r) { if (MODE & 32) OACC[rowv * 68 + (dt * 4 + r) * 4 + q] = __float2int_rn(o[dt][r]); else __hip_atomic_fetch_add(OACC + rowv * 68 + (dt * 4 + r) * 4 + q, __float2int_rn(o[dt][r]), __ATOMIC_RELAXED, __HIP_MEMORY_SCOPE_WORKGROUP); } }
        };
        auto load_kv = [&](int kb, bf16x8 (&kf)[4][2], u32x4 (&vf)[4][2]) {
#pragma unroll
            for (int kt = 0; kt < 4; ++kt)
#pragma unroll
                for (int ks = 0; ks < 2; ++ks) kf[kt][ks] = *(const bf16x8*)(Kg + (size_t)(kb * 64 + 32 * (kt >> 1) + 8 * (c >> 2) + 4 * (kt & 1) + (c & 3)) * PW + ks * 32 + q * 8);
#pragma unroll
            for (int dt = 0; dt < 4; ++dt)
#pragma unroll
                for (int k2 = 0; k2 < 2; ++k2) vf[dt][k2] = *(const u32x4*)(VTg + (size_t)(dt * 16 + c) * S + kb * 64 + 32 * k2 + 8 * q); };
        { bf16x8 kf[4][2]; u32x4 vf[4][2];
            load_kv(cur, kf, vf);
#pragma unroll
            for (int gi = 0; gi < NG; ++gi) block_step(cur, kf, vf, (wave * (4 * NG) + gi * 4 + tk) * 4 + g, true, true, t[gi], true);
            if (cur > 0) { asm volatile("s_waitcnt lgkmcnt(0)" ::: "memory"); load_kv(0, kf, vf);
#pragma unroll
                for (int gi = 0; gi < NG; ++gi) block_step(0, kf, vf, (wave * (4 * NG) + gi * 4 + tk) * 4 + g, true, false, 0, false); } }
        __syncthreads();
        { auto process = [&](int kb, const bf16x8 (&kf)[4][2], const u32x4 (&vf)[4][2]) {
                const unsigned wsel = sm_all[lane * 8 + (kb >> 5)];
                unsigned long long mm = __ballot((wsel >> (kb & 31)) & 1u);
                while (mm != 0ull) { int tj[4]; int nt = 0;
#pragma unroll
                    for (int j = 0; j < 4; ++j) { const bool has = mm != 0ull; tj[j] = has ? (int)__builtin_ctzll(mm) : 0; nt += has ? 1 : 0; mm = has ? (mm & (mm - 1ull)) : 0ull; }
                    const int j = c >> 2; const int mytok = j == 0 ? tj[0] : j == 1 ? tj[1] : j == 2 ? tj[2] : tj[3];
                    block_step(kb, kf, vf, mytok * 4 + g, j < nt, false, 0, false); } };
            bf16x8 kfA[4][2], kfB[4][2]; u32x4 vfA[4][2], vfB[4][2];
            auto take4 = [&](unsigned long long& mm, int& rowv, bool& ok) { int tj[4]; int nt = 0;
#pragma unroll
                for (int j = 0; j < 4; ++j) { const bool has = mm != 0ull; tj[j] = has ? (int)__builtin_ctzll(mm) : 0; nt += has ? 1 : 0; mm = has ? (mm & (mm - 1ull)) : 0ull; }
                const int j = c >> 2; const int mytok = j == 0 ? tj[0] : j == 1 ? tj[1] : j == 2 ? tj[2] : tj[3]; rowv = mytok * 4 + g; ok = j < nt; };
            if (!(MODE & 64)) for (int kb = wave == 0 ? 8 : wave; kb < cur; kb += 16) {
                load_kv(kb, kfA, vfA);
                if (kb + 8 < cur) { load_kv(kb + 8, kfB, vfB);
                    unsigned long long mA = __ballot((sm_all[lane * 8 + (kb >> 5)] >> (kb & 31)) & 1u), mB = __ballot((sm_all[lane * 8 + ((kb + 8) >> 5)] >> ((kb + 8) & 31)) & 1u);
                    while (mA != 0ull && mB != 0ull) { int ra, rb; bool oa, ob; take4(mA, ra, oa); take4(mB, rb, ob);
                        block_step(kb, kfA, vfA, ra, oa, false, 0, false); block_step(kb + 8, kfB, vfB, rb, ob, false, 0, false); }
                    while (mA != 0ull) { int ra; bool oa; take4(mA, ra, oa); block_step(kb, kfA, vfA, ra, oa, false, 0, false); }
                    while (mB != 0ull) { int rb; bool ob; take4(mB, rb, ob); block_step(kb + 8, kfB, vfB, rb, ob, false, 0, false); }
                } else process(kb, kfA, vfA);
            } }
        __syncthreads();
#pragma unroll
        for (int gi = 0; gi < NG; ++gi) { const int row = (wave * (4 * NG) + gi * 4 + tk) * 4 + g; const float lt = (float)LACC[row]; const float gg = sigm(bflo((unsigned)P[(size_t)t[gi] * PW + PC_BG + hq * 3 + 1])); const float sc = lt > 0.f ? gg / lt : 0.f;
            bf16_t* O = (bf16_t*)(ws + WS_NSAO) + (size_t)t[gi] * 768 + hq * 64;
#pragma unroll
            for (int dt = 0; dt < 4; ++dt) { const u32x2 ov = *(const u32x2*)(O + dt * 16 + 4 * q); const LAS int* ip = OACC + row * 68 + dt * 16 + q; const f32x4 v = (f32x4){(float)ip[0], (float)ip[4], (float)ip[8], (float)ip[12]} * sc;
                u32x2 w; w.x = cvt_pk_bf16(bflo(ov.x) + v[0], bfhi(ov.x) + v[1]); w.y = cvt_pk_bf16(bflo(ov.y) + v[2], bfhi(ov.y) + v[3]); if ((MODE & 16) || v[0] == 12345.678f) *(u32x2*)(O + dt * 16 + 4 * q) = w; } }
        __syncthreads();
    }
    if (MODE & 8) {
        FState st[NG]; bf16x8 qw[NG][2];
#pragma unroll
        for (int gi = 0; gi < NG; ++gi) { fs_init(st[gi]);
#pragma unroll
            for (int ks = 0; ks < 2; ++ks) qw[gi][ks] = *(const bf16x8*)(P + (size_t)t[gi] * PW + PC_BQ + hq * 64 + ks * 32 + q * 8); }
        const int kb0 = (t0 - 511 > 0 ? t0 - 511 : 0) >> 6, kb1 = cur + 1;
        kv_loop(lds, P + PC_KW + kh * 64, PW, S - 1, (const bf16_t*)(ws + WS_VTW) + (size_t)kh * 64 * S, S, kb0, kb1, tid, [&](int kb, ldsp B) {
#pragma unroll
            for (int gi = 0; gi < NG; ++gi) { const int hi = t[gi] - kb * 64 - 8 * q, lo = hi - 511;
                if (kb > kb0 + 1 && kb < cur) flash_step<0>(B, ko, qw[gi], st[gi], true, [](int) { return true; });
                else flash_step<1>(B, ko, qw[gi], st[gi], true, [&](int kk) { return kk <= hi && kk >= lo; }); }
        });
#pragma unroll
        for (int gi = 0; gi < NG; ++gi) { const float lt = fs_ltot(st[gi]); const float gg = sigm(bflo((unsigned)P[(size_t)t[gi] * PW + PC_BG + hq * 3 + 2])); const float sc = lt > 0.f ? gg / lt : 0.f;
            bf16_t* O = (bf16_t*)(ws + WS_NSAO) + (size_t)t[gi] * 768 + hq * 64;
#pragma unroll
            for (int dt = 0; dt < 4; ++dt) { const u32x2 ov = *(const u32x2*)(O + dt * 16 + 4 * q); const f32x4 v = st[gi].o[dt] * sc;
                u32x2 w; w.x = cvt_pk_bf16(bflo(ov.x) + v[0], bfhi(ov.x) + v[1]); w.y = cvt_pk_bf16(bflo(ov.y) + v[2], bfhi(ov.y) + v[3]); if ((MODE & 16) || v[0] == 12345.678f) *(u32x2*)(O + dt * 16 + 4 * q) = w; } }
    }
}

__device__ __forceinline__ void dil_task(unsigned char* ws, int task, int lane) {
    const int c = lane & 15, q = lane >> 4;
    const int hh = task >> 10, u = task & 1023, gi = hh >> 2, dsh = 2 * gi  , Ls = S >> dsh, gpr = Ls >> 4  ;
    const int r = u / gpr, i0 = (u - r * gpr) * 16, ib = i0 - 128;
    bf16_t* P = (bf16_t*)(ws + WS_P);
    const int t = ((i0 + c) << dsh) + r;
    bf16x8 qf[2];
#pragma unroll
    for (int ks = 0; ks < 2; ++ks) qf[ks] = *(const bf16x8*)(P + (size_t)t * PW + PC_CQ + hh * 64 + ks * 32 + q * 8);
    f32x4 s[9];
#pragma unroll
    for (int kt = 0; kt < 9; ++kt) { int ik = ib + kt * 16 + c; ik = ik < 0 ? 0 : ik; const bf16_t* kp = P + (size_t)((ik << dsh) + r) * PW + PC_CK + hh * 64 + q * 8;
        const bf16x8 a0 = *(const bf16x8*)kp, a1 = *(const bf16x8*)(kp + 32);
        s[kt] = mfma16(a0, qf[0], (f32x4){0.f, 0.f, 0.f, 0.f}); s[kt] = mfma16(a1, qf[1], s[kt]); }
    const int base = 4 * q - 128 - c; float mx = -1e30f;
#pragma unroll
    for (int kt = 0; kt < 9; ++kt)
#pragma unroll
        for (int rr = 0; rr < 4; ++rr) { const int rel = base + kt * 16 + rr; const bool v = rel <= 0 && rel >= -128 && (ib + kt * 16 + 4 * q + rr) >= 0; s[kt][rr] = v ? s[kt][rr] : -1e30f; mx = fmaxf(mx, s[kt][rr]); }
    mx = colmax4(mx);
    float l = 0.f;
#pragma unroll
    for (int kt = 0; kt < 9; ++kt)
#pragma unroll
        for (int rr = 0; rr < 4; ++rr) { const float p = __builtin_amdgcn_exp2f(s[kt][rr] - mx); s[kt][rr] = p; l += p; }
    { float lt = l; lt += __shfl_xor(lt, 16); lt += __shfl_xor(lt, 32); l = lt; }
    const bf16_t* VT = (const bf16_t*)(ws + WS_VTC) + (size_t)hh * 64 * S + (size_t)r * Ls;
    f32x4 o[4];
#pragma unroll
    for (int dt = 0; dt < 4; ++dt) o[dt] = (f32x4){0.f, 0.f, 0.f, 0.f};
#pragma unroll
    for (int k2 = 0; k2 < 5; ++k2) {
        u32x4 pw; pw.x = cvt_pk_bf16(s[2 * k2][0], s[2 * k2][1]); pw.y = cvt_pk_bf16(s[2 * k2][2], s[2 * k2][3]);
        if (k2 < 4) { pw.z = cvt_pk_bf16(s[2 * k2 + 1][0], s[2 * k2 + 1][1]); pw.w = cvt_pk_bf16(s[2 * k2 + 1][2], s[2 * k2 + 1][3]); } else { pw.z = 0u; pw.w = 0u; }
        const bf16x8 pb = __builtin_bit_cast(bf16x8, pw);
        int c0 = ib + 32 * k2 + 4 * q; c0 = c0 < 0 ? 0 : c0; int c1 = ib + 32 * k2 + 16 + 4 * q; c1 = c1 < 0 ? 0 : c1; c1 = (k2 < 4) ? c1 : c0;
#pragma unroll
        for (int dt = 0; dt < 4; ++dt) { const bf16_t* vp = VT + (size_t)(dt * 16 + c) * S;
            const u32x2 lo = *(const u32x2*)(vp + c0), hi = *(const u32x2*)(vp + c1);
            u32x4 aw; aw.x = lo.x; aw.y = lo.y; aw.z = hi.x; aw.w = hi.y;
            o[dt] = mfma16(__builtin_bit_cast(bf16x8, aw), pb, o[dt]); } }
    const float il = 1.f / l;
    bf16_t* O = P + (size_t)t * PW + PC_AX + hh * 64;
#pragma unroll
    for (int dt = 0; dt < 4; ++dt) { const f32x4 v = o[dt] * il; u32x2 w; w.x = cvt_pk_bf16(v[0], v[1]); w.y = cvt_pk_bf16(v[2], v[3]); *(u32x2*)(O + dt * 16 + 4 * q) = w; }
    if (q == 0) ((float*)(ws + WS_LSE))[(size_t)hh * S + t] = mx + __builtin_amdgcn_logf(l);
}
__device__ __forceinline__ void dil_combine(unsigned char* ws, int tid) {
    const bf16_t* P = (const bf16_t*)(ws + WS_P); const float* LSE = (const float*)(ws + WS_LSE); bf16_t* DO = (bf16_t*)(ws + WS_DILO);
    for (int i = blockIdx.x * NT + tid; i < S * 32; i += gridDim.x * NT) { const int t = i >> 5, j = (i >> 3) & 3, ch = i & 7;
        const float l0 = LSE[(size_t)j * S + t], l1 = LSE[(size_t)(4 + j) * S + t], l2 = LSE[(size_t)(8 + j) * S + t];
        const float m = fmaxf(l0, fmaxf(l1, l2)); float w0 = __builtin_amdgcn_exp2f(l0 - m), w1 = __builtin_amdgcn_exp2f(l1 - m), w2 = __builtin_amdgcn_exp2f(l2 - m);
        const float inv = 1.f / (w0 + w1 + w2); w0 *= inv; w1 *= inv; w2 *= inv;
        const bf16_t* pr = P + (size_t)t * PW + PC_AX + j * 64 + ch * 8;
        const u32x4 a = *(const u32x4*)pr, b = *(const u32x4*)(pr + 256), cc = *(const u32x4*)(pr + 512);
        u32x4 o; o.x = cvt_pk_bf16(w0 * bflo(a.x) + w1 * bflo(b.x) + w2 * bflo(cc.x), w0 * bfhi(a.x) + w1 * bfhi(b.x) + w2 * bfhi(cc.x));
        o.y = cvt_pk_bf16(w0 * bflo(a.y) + w1 * bflo(b.y) + w2 * bflo(cc.y), w0 * bfhi(a.y) + w1 * bfhi(b.y) + w2 * bfhi(cc.y));
        o.z = cvt_pk_bf16(w0 * bflo(a.z) + w1 * bflo(b.z) + w2 * bflo(cc.z), w0 * bfhi(a.z) + w1 * bfhi(b.z) + w2 * bfhi(cc.z));
        o.w = cvt_pk_bf16(w0 * bflo(a.w) + w1 * bflo(b.w) + w2 * bflo(cc.w), w0 * bfhi(a.w) + w1 * bfhi(b.w) + w2 * bfhi(cc.w));
        *(u32x4*)(DO + (size_t)t * 256 + j * 64 + ch * 8) = o; }
}
__device__ __forceinline__ void cmp_item(unsigned char* ws, ldsp lds, int it, int tid) {
    asm volatile("" : "+v"(tid));
    const int lane = tid & 63, wave = __builtin_amdgcn_readfirstlane(tid >> 6), c = lane & 15, q = lane >> 4;
    const int kv = it / 96, rem = it % 96, h = rem / 32, c0 = (rem % 32) * 32;
    const bf16_t* P = (const bf16_t*)(ws + WS_P) + (kv ? PC_VC : PC_KC) + h * 64;
    for (int idx = tid; idx < 528 * 8; idx += NT) { const int tl = idx >> 3, ch = idx & 7; int tok = 16 * c0 + tl; tok = tok < S ? tok : S - 1;
        const u32x4 v = *(const u32x4*)(P + (size_t)tok * PW + ch * 8);
        *(LAS u32x4*)(lds + ((tl & 15) * 34 + (tl >> 4)) * 144 + ch * 16) = v; }
    __syncthreads();
    const bf16_t* W1t = (const bf16_t*)(ws + WS_WT + (kv ? WT_C1V : WT_C1K));
    f32x4 acc[2][2];
#pragma unroll
    for (int i = 0; i < 2; ++i)
#pragma unroll
        for (int j = 0; j < 2; ++j) acc[i][j] = (f32x4){0.f, 0.f, 0.f, 0.f};
    const bf16_t* wp0 = W1t + (size_t)((2 * wave) * 16 + c) * 2048 + 8 * q; const bf16_t* wp1 = wp0 + (size_t)16 * 2048;
#pragma unroll 8
    for (int ks = 0; ks < 64; ++ks) { const int l_ = ks >> 1, d0 = (ks & 1) * 32;
        const bf16x8 b0 = *(const bf16x8*)(wp0 + ks * 32), b1 = *(const bf16x8*)(wp1 + ks * 32);
        ldsp ap = lds + ((l_ & 15) * 34 + c + (l_ >> 4)) * 144 + (d0 + 8 * q) * 2;
        const bf16x8 a0 = *(const LAS bf16x8*)(ap), a1 = *(const LAS bf16x8*)(ap + 16 * 144);
        acc[0][0] = mfma16(a0, b0, acc[0][0]); acc[0][1] = mfma16(a0, b1, acc[0][1]); acc[1][0] = mfma16(a1, b0, acc[1][0]); acc[1][1] = mfma16(a1, b1, acc[1][1]); }
    LAS bf16_t* Hs = (LAS bf16_t*)(lds + 78336);
    const float* bp = (const float*)(ws + WS_BIASP) + kv * 8 * 256;
#pragma unroll
    for (int nl = 0; nl < 2; ++nl) { const int n = (2 * wave + nl) * 16 + c; float b = 0.f;
#pragma unroll
        for (int p = 0; p < 8; ++p) b += bp[p * 256 + n];
#pragma unroll
        for (int mt = 0; mt < 2; ++mt)
#pragma unroll
            for (int r = 0; r < 4; ++r) { const float v = gelu_t(acc[mt][nl][r] + b); Hs[(mt * 16 + 4 * q + r) * 264 + n] = (bf16_t)(cvt_pk_bf16(v, v) & 0xffffu); } }
    __syncthreads();
    const bf16_t* W2t = (const bf16_t*)(ws + WS_WT + (kv ? WT_C2V : WT_C2K));
    const int mt = wave >> 2, nt = wave & 3;
    f32x4 a2 = (f32x4){0.f, 0.f, 0.f, 0.f};
#pragma unroll
    for (int ks = 0; ks < 8; ++ks) { const bf16x8 av = *(const LAS bf16x8*)((ldsp)Hs + ((mt * 16 + c) * 264 + ks * 32 + 8 * q) * 2);
        const bf16x8 bv = *(const bf16x8*)(W2t + (size_t)(nt * 16 + c) * 256 + ks * 32 + 8 * q); a2 = mfma16(av, bv, a2); }
    if (kv == 0) { bf16_t* KC = (bf16_t*)(ws + WS_KC) + (size_t)h * 1024 * 64;
#pragma unroll
        for (int r = 0; r < 4; ++r) KC[(size_t)(c0 + mt * 16 + 4 * q + r) * 64 + nt * 16 + c] = (bf16_t)(cvt_pk_bf16(a2[r], a2[r]) & 0xffffu); }
    else { bf16_t* VCT = (bf16_t*)(ws + WS_VCT) + (size_t)h * 64 * 1024; u32x2 w; w.x = cvt_pk_bf16(a2[0], a2[1]); w.y = cvt_pk_bf16(a2[2], a2[3]);
        *(u32x2*)(VCT + (size_t)(nt * 16 + c) * 1024 + c0 + mt * 16 + 4 * q) = w; }
    __syncthreads();
}

__device__ __forceinline__ void lru_tile_item(unsigned char* ws, ldsp lds, int it, int l, int tid) {
    asm volatile("" : "+v"(tid));
    const int lane = tid & 63, wave = __builtin_amdgcn_readfirstlane(tid >> 6), c = lane & 15, q = lane >> 4;
    const int ci = it / 6, b = it % 6, t0 = ci * 64, ch0 = b * 128;
    const bf16_t* P = (const bf16_t*)(ws + WS_P);
    { const int tok = tid >> 3, cg = (tid & 7) * 16; float xc[16];
        const float* cb = inp(I_CONVB) + l * 768 + ch0 + cg; const float* cw = inp(I_CONVW) + (size_t)l * 4 * 768 + ch0 + cg;
#pragma unroll
        for (int i4 = 0; i4 < 4; ++i4) { const f32x4 b4 = *(const f32x4*)(cb + 4 * i4); xc[4 * i4] = b4[0]; xc[4 * i4 + 1] = b4[1]; xc[4 * i4 + 2] = b4[2]; xc[4 * i4 + 3] = b4[3]; }
#pragma unroll
        for (int j = 0; j < 4; ++j) { const int tt = t0 + tok - 3 + j;
            if (tt >= 0) { const u32x4 v0 = *(const u32x4*)(P + (size_t)tt * PW + PC_AX + ch0 + cg), v1 = *(const u32x4*)(P + (size_t)tt * PW + PC_AX + ch0 + cg + 8);
                const float x[16] = {bflo(v0.x), bfhi(v0.x), bflo(v0.y), bfhi(v0.y), bflo(v0.z), bfhi(v0.z), bflo(v0.w), bfhi(v0.w), bflo(v1.x), bfhi(v1.x), bflo(v1.y), bfhi(v1.y), bflo(v1.z), bfhi(v1.z), bflo(v1.w), bfhi(v1.w)};
#pragma unroll
                for (int i4 = 0; i4 < 4; ++i4) { const f32x4 w4 = *(const f32x4*)(cw + j * 768 + 4 * i4);
#pragma unroll
                    for (int e = 0; e < 4; ++e) xc[4 * i4 + e] += w4[e] * x[4 * i4 + e]; } } }
        u32x4 w0, w1; w0.x = cvt_pk_bf16(xc[0], xc[1]); w0.y = cvt_pk_bf16(xc[2], xc[3]); w0.z = cvt_pk_bf16(xc[4], xc[5]); w0.w = cvt_pk_bf16(xc[6], xc[7]);
        w1.x = cvt_pk_bf16(xc[8], xc[9]); w1.y = cvt_pk_bf16(xc[10], xc[11]); w1.z = cvt_pk_bf16(xc[12], xc[13]); w1.w = cvt_pk_bf16(xc[14], xc[15]);
        *(LAS u32x4*)(lds + tok * 272 + cg * 2) = w0; *(LAS u32x4*)(lds + tok * 272 + cg * 2 + 16) = w1; }
    __syncthreads();
    const bf16_t* Wl = (const bf16_t*)(ws + WS_WT + WT_LRU) + (size_t)b * 256 * 128;
    f32x4 acc[2][4];
#pragma unroll
    for (int i = 0; i < 2; ++i)
#pragma unroll
        for (int j = 0; j < 4; ++j) acc[i][j] = (f32x4){0.f, 0.f, 0.f, 0.f};
#pragma unroll
    for (int ks = 0; ks < 4; ++ks) { const bf16x8 b0 = *(const bf16x8*)(Wl + (size_t)(wave * 16 + c) * 128 + ks * 32 + 8 * q), b1 = *(const bf16x8*)(Wl + (size_t)(128 + wave * 16 + c) * 128 + ks * 32 + 8 * q);
#pragma unroll
        for (int mt = 0; mt < 4; ++mt) { const bf16x8 av = *(const LAS bf16x8*)(lds + (mt * 16 + c) * 272 + (ks * 32 + 8 * q) * 2); acc[0][mt] = mfma16(av, b0, acc[0][mt]); acc[1][mt] = mfma16(av, b1, acc[1][mt]); } }
    LAS float* sa = (LAS float*)(lds + 17408); LAS float* su = (LAS float*)(lds + 17408 + 33024);
    { const int ch = wave * 16 + c; const float ba = inp(I_LRUBA)[l * 768 + ch0 + ch], bi = inp(I_LRUBI)[l * 768 + ch0 + ch]; const float sp = log1pf(__expf(-inp(I_LAM)[l * 768 + ch0 + ch]));
#pragma unroll
        for (int mt = 0; mt < 4; ++mt)
#pragma unroll
            for (int r = 0; r < 4; ++r) { const int tok = mt * 16 + 4 * q + r; const float rg = sigm(acc[0][mt][r] + ba), ig = sigm(acc[1][mt][r] + bi);
                const float la = -8.f * rg * sp; const float av = __expf(la); const float mult = sqrtf(fmaxf(1.f - av * av, 0.f));
                const float xv = bflo((unsigned)*(const LAS bf16_t*)(lds + tok * 272 + ch * 2));
                sa[tok * 129 + ch] = av; su[tok * 129 + ch] = mult * ig * xv; } }
    __syncthreads();
    if (tid < 128) { const int ch = tid; float h = 0.f, pc = 1.f;
        bf16_t* HL = (bf16_t*)(ws + WS_HLOC) + (size_t)t0 * 768 + ch0 + ch; bf16_t* CP = (bf16_t*)(ws + WS_CUMP) + (size_t)t0 * 768 + ch0 + ch;
#pragma unroll 8
        for (int t = 0; t < 64; ++t) { const float av = sa[t * 129 + ch], uv = su[t * 129 + ch]; h = av * h + uv; pc *= av;
            HL[(size_t)t * 768] = (bf16_t)(cvt_pk_bf16(h, h) & 0xffffu); CP[(size_t)t * 768] = (bf16_t)(cvt_pk_bf16(pc, pc) & 0xffffu); }
        ((float*)(ws + WS_ATOT))[ci * 768 + ch0 + ch] = pc; ((float*)(ws + WS_HEND))[ci * 768 + ch0 + ch] = h; }
    __syncthreads();
}
__device__ __forceinline__ void lru_apply_item(unsigned char* ws, ldsp lds, int it, int tid) {
    asm volatile("" : "+v"(tid));
    const int g16 = it / 6, b = it % 6, ch0 = b * 128, c0 = g16 * 16;
    LAS float* sA = (LAS float*)lds; LAS float* sH = sA + 512; LAS float* sC = sH + 512;
    const float* at = (const float*)(ws + WS_ATOT) + ch0; const float* he = (const float*)(ws + WS_HEND) + ch0;
    { const int ch = tid & 127, part = tid >> 7; const int j0 = part * c0 / 4, j1 = (part + 1) * c0 / 4; float A = 1.f, H = 0.f;
#pragma unroll 16
        for (int j = j0; j < j1; ++j) { const float av = at[(size_t)j * 768 + ch], hv = he[(size_t)j * 768 + ch]; H = av * H + hv; A *= av; }
        sA[part * 128 + ch] = A; sH[part * 128 + ch] = H; }
    __syncthreads();
    if (tid < 128) { float cr = 0.f;
#pragma unroll
        for (int p = 0; p < 4; ++p) cr = sA[p * 128 + tid] * cr + sH[p * 128 + tid];
        sC[tid] = cr; }
    __syncthreads();
#pragma unroll 1
    for (int k = 0; k < 16; ++k) { const int ci = c0 + k, t0 = ci * 64;
        float na = 0.f, nh = 0.f; if (tid < 128) { na = at[(size_t)ci * 768 + tid]; nh = he[(size_t)ci * 768 + tid]; }
        { const int tok = tid >> 3, cg = (tid & 7) * 16; const size_t ro = (size_t)(t0 + tok) * 768 + ch0 + cg;
            const bf16_t* HL = (const bf16_t*)(ws + WS_HLOC) + ro; const bf16_t* CP = (const bf16_t*)(ws + WS_CUMP) + ro; const bf16_t* G = (const bf16_t*)(ws + WS_P) + (size_t)(t0 + tok) * PW + PC_AG + ch0 + cg;
            bf16_t* Y = (bf16_t*)(ws + WS_YA) + ro;
#pragma unroll
            for (int hf = 0; hf < 2; ++hf) { const u32x4 hv = *(const u32x4*)(HL + 8 * hf), cv = *(const u32x4*)(CP + 8 * hf), gv = *(const u32x4*)(G + 8 * hf); const LAS float* cc = sC + cg + 8 * hf;
                u32x4 w; w.x = cvt_pk_bf16((bflo(hv.x) + bflo(cv.x) * cc[0]) * bflo(gv.x), (bfhi(hv.x) + bfhi(cv.x) * cc[1]) * bfhi(gv.x));
                w.y = cvt_pk_bf16((bflo(hv.y) + bflo(cv.y) * cc[2]) * bflo(gv.y), (bfhi(hv.y) + bfhi(cv.y) * cc[3]) * bfhi(gv.y));
                w.z = cvt_pk_bf16((bflo(hv.z) + bflo(cv.z) * cc[4]) * bflo(gv.z), (bfhi(hv.z) + bfhi(cv.z) * cc[5]) * bfhi(gv.z));
                w.w = cvt_pk_bf16((bflo(hv.w) + bflo(cv.w) * cc[6]) * bflo(gv.w), (bfhi(hv.w) + bfhi(cv.w) * cc[7]) * bfhi(gv.w));
                *(u32x4*)(Y + 8 * hf) = w; } }
        __syncthreads();
        if (tid < 128) sC[tid] = na * sC[tid] + nh;
        __syncthreads(); }
}
__device__ __forceinline__ void vt_item(unsigned char* ws, ldsp lds, int tt, int tid) {
    asm volatile("" : "+v"(tid));
    const int lane = tid & 63, wave = __builtin_amdgcn_readfirstlane(tid >> 6);
    const bf16_t* P = (const bf16_t*)(ws + WS_P);
#pragma unroll 1
    for (int grp = 0; grp < 3; ++grp) {
        { const int tok = tid >> 3, ch = tid & 7;
#pragma unroll
            for (int s6 = 0; s6 < 6; ++s6) { const int s = grp * 6 + s6; const int sc = s < 3 ? PC_VS + s * 64 : s < 6 ? PC_VW + (s - 3) * 64 : PC_CV + (s - 6) * 64;
                const u32x4 v = *(const u32x4*)(P + (size_t)(tt * 64 + tok) * PW + sc + ch * 8); *(LAS u32x4*)(lds + tok * 784 + (s6 * 64 + ch * 8) * 2) = v; } }
        __syncthreads();
#pragma unroll
        for (int s6 = 0; s6 < 6; ++s6) { const int s = grp * 6 + s6; unsigned short e[8];
            const int dsel = s < 10 ? 0 : s < 14 ? 1 : 2;
#pragma unroll
            for (int i = 0; i < 8; ++i) { const int tok = dsel == 0 ? wave * 8 + i : dsel == 1 ? (wave & 3) + 4 * (8 * (wave >> 2) + i) : 2 * wave + (i >> 2) + 16 * (i & 3);
                e[i] = *(const LAS unsigned short*)(lds + tok * 784 + (s6 * 64 + lane) * 2); }
            u32x4 w; w.x = e[0] | ((unsigned)e[1] << 16); w.y = e[2] | ((unsigned)e[3] << 16); w.z = e[4] | ((unsigned)e[5] << 16); w.w = e[6] | ((unsigned)e[7] << 16);
            const size_t dofs = s < 3 ? WS_VTS + (size_t)(s * 64 + lane) * S * 2 : s < 6 ? WS_VTW + (size_t)((s - 3) * 64 + lane) * S * 2 : WS_VTC + (size_t)((s - 6) * 64 + lane) * S * 2; bf16_t* dst = (bf16_t*)(ws + dofs);
            if (dsel == 0) *(u32x4*)(dst + tt * 64 + wave * 8) = w;
            else if (dsel == 1) *(u32x4*)(dst + (wave & 3) * (S / 4) + tt * 16 + 8 * (wave >> 2)) = w;
            else { u32x2 w0, w1; w0.x = w.x; w0.y = w.y; w1.x = w.z; w1.y = w.w; *(u32x2*)(dst + (2 * wave) * (S / 16) + tt * 4) = w0; *(u32x2*)(dst + (2 * wave + 1) * (S / 16) + tt * 4) = w1; } }
        __syncthreads();
    }
}

#define ssql ((float*)(wsl + WS_SSQ))
#define Xl ((float*)inp(29))
#define XBl ((bf16_t*)(wsl + WS_XB))
#define ctrl ((unsigned*)(wsl + WS_CTR))
#define wt (wsl + WS_WT)
#define P ((bf16_t*)(wsl + WS_P))
#define HID ((bf16_t*)(wsl + WS_HID))
#define MG ((bf16_t*)(wsl + WS_MERGED))
#define XBAR() do { XcdBarrier xb_; xb_.bar = (unsigned*)(wsl + WS_BAR); xb_.x = xb_xcc_id(); xb_.st = (volatile LAS unsigned*)(lds + LDS_BYTES - 32); xcd_barrier(xb_); } while (0)
#ifndef PH
#define PH 0xFFFF
#endif
__device__ __forceinline__ int next_item(unsigned* ctr, LAS int* slot, int tid) {
    __syncthreads(); if (tid == 0) *slot = (int)atomicAdd(ctr, 1u); __syncthreads(); return *slot;
}
template <class Epi>
__device__ __forceinline__ void run_gemm(ldsp lds, const bf16_t* A, const bf16_t* Bt, int N, int K, const Epi& E) {
    pg8::Gemm g{A, Bt, S, N, K}; pg8::StaticOrder So; So.init(S, N, (int)gridDim.x, (int)blockIdx.x);
    pg8::gemm_phase<Epi, pg8::StaticOrder, true, true>(lds, g, So, E);
}

__global__ void __launch_bounds__(NT, 2) mega(Args a) {
    extern __shared__ __attribute__((aligned(16))) unsigned char lds_raw[];
    ldsp lds = (ldsp)lds_raw;
    LAS int* slot = (LAS int*)(lds + LDS_BYTES - 64);
    cg::grid_group grid = cg::this_grid();
    const int tid = threadIdx.x, lane = tid & 63, wave = tid >> 6;
    const int gw = blockIdx.x * 8 + wave, NGW = gridDim.x * 8;
    unsigned char* ws = (unsigned char*)inp(30);
    float* ssq = (float*)(ws + WS_SSQ); unsigned* ctr = (unsigned*)(ws + WS_CTR);
    float* X = (float*)inp(29); bf16_t* XB = (bf16_t*)(ws + WS_XB);
    for (int m = gw; m < S; m += NGW) {
        const float4* xr = (const float4*)(inp(I_X) + (size_t)m * DM) + lane; float4* orow = (float4*)(X + (size_t)m * DM) + lane; u32x2* xb = (u32x2*)(XB + (size_t)m * DM) + lane;
        float s = 0.f;
#pragma unroll
        for (int j = 0; j < 4; ++j) { const float4 v = xr[64 * j]; s += v.x * v.x + v.y * v.y + v.z * v.z + v.w * v.w; orow[64 * j] = v; u32x2 w; w.x = cvt_pk_bf16(v.x, v.y); w.y = cvt_pk_bf16(v.z, v.w); xb[64 * j] = w; }
        s = wave_sum(s);
        if (lane < 16) ssq[(size_t)m * 16 + lane] = lane == 0 ? s : 0.f;
    }
    if (blockIdx.x == 0 && tid < 64) ctr[tid] = 0u;
    if (blockIdx.x == 0) for (int i = tid; i < XCD_BAR_WORDS; i += NT) ((unsigned*)(ws + WS_BAR))[i] = 0u;
    volatile LAS unsigned* bst = (volatile LAS unsigned*)(lds + LDS_BYTES - 32); if (tid < 2) bst[tid] = 0u;
    prep_phase(ws, 0, 0, lds, tid); prep_phase(ws, 0, 1, lds, tid);
    grid.sync();
    (void)xcd_barrier_post((unsigned*)(ws + WS_BAR), bst);
#pragma unroll 1
    for (int l = 0; l < NL; ++l) {
        int tl = threadIdx.x; asm volatile("" : "+v"(tl));
        unsigned long long wsb = (unsigned long long)ws; asm volatile("" : "+s"(wsb)); unsigned char* wsl = (unsigned char*)(__attribute__((address_space(1))) unsigned char*)wsb;
#if PH & 1
        run_gemm(lds, XBl, (const bf16_t*)(wt + WT_W13A), 5632, 1024, pg8::EpiSwiGLU{HID, ssql});
#endif
#if defined(DUP_X) && (DUP_X & 4)
        XBAR(); run_gemm(lds, XBl, (const bf16_t*)(wt + WT_W13A), 5632, 1024, pg8::EpiSwiGLU{HID, ssql});
#endif
        XBAR(); asm volatile("" : "+s"(wsb)); wsl = (unsigned char*)(__attribute__((address_space(1))) unsigned char*)wsb;
#if PH & 2
        run_gemm(lds, HID, (const bf16_t*)(wt + WT_W2A), 1024, 2816, pg8::EpiResid{Xl, XBl, ssql, 0.5f});
#endif
        XBAR(); asm volatile("" : "+s"(wsb)); wsl = (unsigned char*)(__attribute__((address_space(1))) unsigned char*)wsb;
#if PH & 4
        run_gemm(lds, XBl, (const bf16_t*)(wt + WT_WIN), PW, 1024, pg8::EpiProj{P, ssql});
#endif
#if defined(DUP_X) && (DUP_X & 8)
        XBAR(); run_gemm(lds, XBl, (const bf16_t*)(wt + WT_WIN), PW, 1024, pg8::EpiProj{P, ssql});
#endif
        XBAR(); asm volatile("" : "+s"(wsb)); wsl = (unsigned char*)(__attribute__((address_space(1))) unsigned char*)wsb;
#if PH & 8
        for (;;) { const int it = next_item(ctrl + 2 * l, slot, tl); if (it >= 1984 + PREP_GC_B) break;
            if (it < 192) cmp_item(wsl, lds, it, tl); else if (it < 448) vt_item(wsl, lds, it - 192, tl); else if (it < 1984) lru_tile_item(wsl, lds, it - 448, l, tl); else prep_block_item(wsl, l, 2, it - 1984, lds, tl); }
#endif
#if defined(DUP_X) && (DUP_X & 2)
        XBAR();
        for (;;) { const int it = next_item(ctrl + 24 + l, slot, tl); if (it >= 192 + 256 + 1536) break;
            if (it < 192) cmp_item(wsl, lds, it, tl); else if (it < 448) vt_item(wsl, lds, it - 192, tl); else lru_tile_item(wsl, lds, it - 448, l, tl); }
#endif
        XBAR(); asm volatile("" : "+s"(wsb)); wsl = (unsigned char*)(__attribute__((address_space(1))) unsigned char*)wsb;
#if PH & 16
        { const int nprep = (l + 1 < NL) ? PREP_GA_B + PREP_GB_B : 0;
        for (;;) { const int it = next_item(ctrl + 2 * l + 1, slot, tl); if (it >= 2400 + nprep) break;
            if (it < 96) lru_apply_item(wsl, lds, it, tl); else if (it < 864) { const int ni = it - 96; nsa_item<31>(wsl, lds, 255 - (ni & 255), ni >> 8, tl); } else if (it < 2400) dil_task(wsl, (it - 864) * 8 + (tl >> 6), tl & 63);
            else if (it < 2400 + PREP_GA_B) prep_block_item(wsl, l + 1, 0, it - 2400, lds, tl); else prep_block_item(wsl, l + 1, 1, it - 2400 - PREP_GA_B, lds, tl); } }
#endif
#ifdef DUP_NSA
        XBAR(); asm volatile("" : "+s"(wsb)); wsl = (unsigned char*)(__attribute__((address_space(1))) unsigned char*)wsb;
        for (;;) { const int it = next_item(ctrl + 16 + l, slot, tl); if (it >= 768) break; nsa_item<DUP_NSA>(wsl, lds, 255 - (it & 255), it >> 8, tl); }
#endif
#ifdef DUP_M2ALL
        XBAR(); asm volatile("" : "+s"(wsb)); wsl = (unsigned char*)(__attribute__((address_space(1))) unsigned char*)wsb;
        { const int nprep = (l + 1 < NL) ? PREP_GA_B + PREP_GB_B : 0;
        for (;;) { const int it = next_item(ctrl + 16 + l, slot, tl); if (it >= 2400 + nprep) break;
            if (it < 96) lru_apply_item(wsl, lds, it, tl); else if (it < 864) { const int ni = it - 96; nsa_item<31>(wsl, lds, 255 - (ni & 255), ni >> 8, tl); } else if (it < 2400) dil_task(wsl, (it - 864) * 8 + (tl >> 6), tl & 63);
            else if (it < 2400 + PREP_GA_B) prep_block_item(wsl, l + 1, 0, it - 2400, lds, tl); else prep_block_item(wsl, l + 1, 1, it - 2400 - PREP_GA_B, lds, tl); } }
#endif
        XBAR(); asm volatile("" : "+s"(wsb)); wsl = (unsigned char*)(__attribute__((address_space(1))) unsigned char*)wsb;
        dil_combine(wsl, tl);
        XBAR(); asm volatile("" : "+s"(wsb)); wsl = (unsigned char*)(__attribute__((address_space(1))) unsigned char*)wsb;
#if PH & 32
        run_gemm(lds, (const bf16_t*)(wsl + WS_YA), (const bf16_t*)(wt + WT_UA), 1024, 768, pg8::EpiMerge<0>{MG, P + PC_MA});
        run_gemm(lds, (const bf16_t*)(wsl + WS_NSAO), (const bf16_t*)(wt + WT_UB), 1024, 768, pg8::EpiMerge<1>{MG, P + PC_MB});
        run_gemm(lds, (const bf16_t*)(wsl + WS_DILO), (const bf16_t*)(wt + WT_UC), 1024, 256, pg8::EpiMerge<1>{MG, P + PC_MC});
#endif
        XBAR(); asm volatile("" : "+s"(wsb)); wsl = (unsigned char*)(__attribute__((address_space(1))) unsigned char*)wsb;
#if PH & 64
        run_gemm(lds, MG, (const bf16_t*)(wt + WT_WO), 1024, 1024, pg8::EpiResid{Xl, XBl, ssql, 1.0f});
#endif
        XBAR(); asm volatile("" : "+s"(wsb)); wsl = (unsigned char*)(__attribute__((address_space(1))) unsigned char*)wsb;
#if defined(DUP_X) && (DUP_X & 16)
        for (int k = 0; k < 8; ++k) XBAR();
#endif
#if PH & 128
        run_gemm(lds, XBl, (const bf16_t*)(wt + WT_W13B), 5632, 1024, pg8::EpiSwiGLU{HID, ssql});
#endif
        XBAR(); asm volatile("" : "+s"(wsb)); wsl = (unsigned char*)(__attribute__((address_space(1))) unsigned char*)wsb;
#if PH & 256
        run_gemm(lds, HID, (const bf16_t*)(wt + WT_W2B), 1024, 2816, pg8::EpiResid{Xl, XBl, ssql, 0.5f});
#endif
        XBAR(); asm volatile("" : "+s"(wsb)); wsl = (unsigned char*)(__attribute__((address_space(1))) unsigned char*)wsb;
    }
    int tf = threadIdx.x; asm volatile("" : "+v"(tf));
    unsigned char* wsf = (unsigned char*)inp(30); float* Xf = (float*)inp(29);
    const int lanef = tf & 63; const int gwf = blockIdx.x * 8 + (tf >> 6);
    for (int m = gwf; m < S; m += NGW) {
        float4* orow = (float4*)(Xf + (size_t)m * DM) + lanef; const float4* g = (const float4*)(inp(I_FINN)) + lanef;
        const float r = rsqrtf(pg8::rsum16((const float*)(wsf + WS_SSQ), m) * (1.f / DM) + 1e-6f);
#pragma unroll
        for (int j = 0; j < 4; ++j) { float4 v = orow[64 * j]; const float4 gg = g[64 * j]; v.x *= r * gg.x; v.y *= r * gg.y; v.z *= r * gg.z; v.w *= r * gg.w; orow[64 * j] = v; }
    }
}

#undef ssql
#undef Xl
#undef XBl
#undef ctrl
#undef wt
#undef P
#undef HID
#undef MG
extern "C" void kernel_launch(void* const* d_in, const int* in_sizes, int n_in, void* d_out, int out_size, void* d_ws, size_t ws_size, hipStream_t stream) {
    static int grid_blocks = 0;
    if (!grid_blocks) {
        int dev = 0, cus = 0, per_cu = 0;
        (void)hipGetDevice(&dev);
        (void)hipDeviceGetAttribute(&cus, hipDeviceAttributeMultiprocessorCount, dev);
        (void)hipFuncSetAttribute((const void*)mega, hipFuncAttributeMaxDynamicSharedMemorySize, LDS_BYTES);
        (void)hipOccupancyMaxActiveBlocksPerMultiprocessor(&per_cu, (const void*)mega, NT, LDS_BYTES);
        if (per_cu < 1) per_cu = 1;
        grid_blocks = cus * per_cu;
        if (ws_size < WS_END) { fprintf(stderr, "kernel_launch: workspace too small: %zu < %zu\n", ws_size, (size_t)WS_END); grid_blocks = -1; }
    }
    if (grid_blocks < 0) return;
    Args a{};
    for (int i = 0; i < 29; ++i) a.in[i] = (const float*)d_in[i];
    a.out = (float*)d_out; a.ws = (unsigned char*)d_ws;
    void* args[] = {&a};
    hipError_t e = hipLaunchCooperativeKernel((const void*)mega, dim3(grid_blocks), dim3(NT), args, LDS_BYTES, stream);
    if (e != hipSuccess) fprintf(stderr, "cooperative launch failed: %s (grid %d)\n", hipGetErrorString(e), grid_blocks);
}
```
